# Optimizing an MI355X kernel written in HIP

```python
import jax, jax.numpy as jnp
from jax import lax
import numpy as np

D_MODEL = 1024
BATCH = 16
SEQ = 2048
DEPTH = 1

N_MEM = 256
HEAD_DIM = 64
NORM_EPS = 1e-6
ROPE_THETA = 10000.0
RW_HEADS = 8
RW_WIDTH = RW_HEADS * HEAD_DIM
DECAY_LORA = 64
AAA_LORA = 64
GATE_LORA = 128
RW_GN_EPS = 64e-5
RW_IN = 3 * RW_WIDTH + DECAY_LORA + AAA_LORA + GATE_LORA
NSA_HEADS = 8
NSA_KV_GROUPS = 2
NSA_HPG = NSA_HEADS // NSA_KV_GROUPS
NSA_WIDTH = NSA_HEADS * HEAD_DIM
KV_WIDTH = NSA_KV_GROUPS * HEAD_DIM
CMP_BLOCK = 32
CMP_STRIDE = 16
CMP_HIDDEN = 128
SEL_BLOCK = 64
SEL_TOPK = 8
WINDOW = 512
Q_CHUNK = 32
XA_HEADS = 4
XA_HEAD_DIM = D_MODEL // XA_HEADS
D_FF = -(-8 * D_MODEL // (3 * 256)) * 256
IN_SIZES = [RW_IN, NSA_WIDTH] + [KV_WIDTH] * 6 + [3 * NSA_HEADS, 2 * D_MODEL]
D_IN = RW_IN + NSA_WIDTH + 6 * KV_WIDTH + 3 * NSA_HEADS + 2 * D_MODEL

kernel_name = 'hybrid_rwkv7_nsa_block'


def split_cols(p, sizes):
    return jnp.split(p, np.cumsum(sizes)[:-1].tolist(), axis=-1)


def rms_norm(x, g):
    xf = x.astype(jnp.float32)
    y = xf * lax.rsqrt(jnp.mean(xf * xf, axis=-1, keepdims=True) + NORM_EPS)
    return (y * g.astype(jnp.float32)).astype(x.dtype)


def rope(x, pos):
    half = x.shape[-1] // 2
    inv_freq = ROPE_THETA ** (-jnp.arange(half, dtype=jnp.float32) / half)
    ang = pos.astype(jnp.float32)[:, None] * inv_freq[None, :]
    cos, sin = jnp.cos(ang)[:, None, :], jnp.sin(ang)[:, None, :]
    xf = x.astype(jnp.float32)
    x1, x2 = xf[..., :half], xf[..., half:]
    return jnp.concatenate([x1 * cos - x2 * sin, x2 * cos + x1 * sin], axis=-1).astype(x.dtype)


def masked_softmax(s, mask):
    s = jnp.where(mask, s.astype(jnp.float32), -1e30)
    e = jnp.where(mask, jnp.exp(s - jnp.max(s, axis=-1, keepdims=True)), 0.0)
    return e / jnp.maximum(jnp.sum(e, axis=-1, keepdims=True), 1e-30)


def token_shift(p, mu):
    prev = jnp.pad(p[:, :-1], ((0, 0), (1, 0), (0, 0)))
    return p + mu * (prev - p)


def rwkv7_time_mix(p_rw, w_up, w0, a_up, a0, g_up, k_k, k_a, r_k, ln_g, ln_b):
    B, T, _ = p_rw.shape
    f32 = jnp.float32
    r, k, v, xw, xa, xg = split_cols(p_rw, [RW_WIDTH] * 3 + [DECAY_LORA, AAA_LORA, GATE_LORA])
    w_log = -jax.nn.softplus(-(w0 + jnp.tanh(xw) @ w_up).astype(f32)) - 0.5
    decay = jnp.exp(-jnp.exp(w_log))
    a = jax.nn.sigmoid((a0 + xa @ a_up).astype(f32))
    g = jax.nn.sigmoid(xg) @ g_up

    def heads(t):
        return t.astype(f32).reshape(B, T, RW_HEADS, HEAD_DIM)

    r, k, v, decay, a = heads(r), heads(k), heads(v), heads(decay), heads(a)
    kk = k * k_k.astype(f32).reshape(RW_HEADS, HEAD_DIM)
    kk = kk * lax.rsqrt(jnp.maximum(jnp.sum(kk * kk, axis=-1, keepdims=True), 1e-12))
    k = k * (1.0 + (a - 1.0) * k_a.astype(f32).reshape(RW_HEADS, HEAD_DIM))

    def step(S, inp):
        r_t, w_t, k_t, v_t, kk_t, a_t = inp
        sa = jnp.einsum('bhij,bhj->bhi', S, -kk_t)
        S = S * w_t[:, :, None, :] + sa[..., :, None] * (kk_t * a_t)[..., None, :] \
            + v_t[..., :, None] * k_t[..., None, :]
        return S, jnp.einsum('bhij,bhj->bhi', S, r_t)

    xs = tuple(jnp.moveaxis(t, 1, 0) for t in (r, decay, k, v, kk, a))
    S0 = jnp.zeros((B, RW_HEADS, HEAD_DIM, HEAD_DIM), f32)
    _, ys = lax.scan(step, S0, xs)
    y = jnp.moveaxis(ys, 0, 1)
    mu = jnp.mean(y, axis=-1, keepdims=True)
    var = jnp.mean(jnp.square(y - mu), axis=-1, keepdims=True)
    y = ((y - mu) * lax.rsqrt(var + RW_GN_EPS)).reshape(B, T, RW_WIDTH)
    y = y * ln_g.astype(f32) + ln_b.astype(f32)
    bonus = (jnp.sum(r * k * r_k.astype(f32), axis=-1, keepdims=True) * v).reshape(B, T, RW_WIDTH)
    return ((y + bonus) * g.astype(f32)).astype(p_rw.dtype)


def nsa_attention(q, kc, vc, ks, vs, kw, vw, gate_logits, pe_k, pe_v, ck1, ck2, cv1, cv2):
    B, T, _ = q.shape
    G, HPG, D = NSA_KV_GROUPS, NSA_HPG, HEAD_DIM
    scale = D ** -0.5
    pos = jnp.arange(T)
    q = q.reshape(B, T, NSA_HEADS, D)
    q_rot = rope(q, pos).reshape(B, T, G, HPG, D)
    q_cmp = q.reshape(B, T, G, HPG, D)
    kc, vc, ks, vs, kw, vw = (t.reshape(B, T, G, D) for t in (kc, vc, ks, vs, kw, vw))
    ks, kw = rope(ks, pos), rope(kw, pos)

    n_cmp = (T - CMP_BLOCK) // CMP_STRIDE + 1
    cmp_start = np.arange(n_cmp) * CMP_STRIDE
    cmp_idx = cmp_start[:, None] + np.arange(CMP_BLOCK)[None, :]
    cmp_last = jnp.asarray(cmp_start + CMP_BLOCK - 1)

    def compress(t, pe, w1, w2):
        blk = t[:, cmp_idx] + pe[:, None, :]
        blk = jnp.transpose(blk, (0, 1, 3, 2, 4)).reshape(B, n_cmp, G, CMP_BLOCK * D)
        return jax.nn.gelu(blk @ w1) @ w2

    k_cmp = compress(kc, pe_k, ck1, ck2)
    v_cmp = compress(vc, pe_v, cv1, cv2)

    n_sel = T // SEL_BLOCK
    top_k = min(SEL_TOPK, n_sel)
    sel_start = np.arange(n_sel) * SEL_BLOCK
    overlap = np.clip(np.minimum(cmp_start[:, None] + CMP_BLOCK, sel_start[None, :] + SEL_BLOCK)
                      - np.maximum(cmp_start[:, None], sel_start[None, :]), 0, None)
    overlap = jnp.asarray(overlap / CMP_BLOCK, dtype=jnp.float32)
    ks_blk = jnp.transpose(ks.reshape(B, n_sel, SEL_BLOCK, G, D), (0, 3, 1, 2, 4))
    vs_blk = jnp.transpose(vs.reshape(B, n_sel, SEL_BLOCK, G, D), (0, 3, 1, 2, 4))
    kw_pad = jnp.pad(kw, ((0, 0), (WINDOW, 0), (0, 0), (0, 0)))
    vw_pad = jnp.pad(vw, ((0, 0), (WINDOW, 0), (0, 0), (0, 0)))
    b_ix = jnp.arange(B)[:, None, None, None]
    g_ix = jnp.arange(G)[None, :, None, None]
    blk_ids = jnp.arange(n_sel)
    span = Q_CHUNK + WINDOW

    def chunk(c):
        t0 = c * Q_CHUNK
        tq = t0 + jnp.arange(Q_CHUNK)
        qc = lax.dynamic_slice_in_dim(q_cmp, t0, Q_CHUNK, axis=1)
        qr = lax.dynamic_slice_in_dim(q_rot, t0, Q_CHUNK, axis=1)
        s = jnp.einsum('bcghd,bngd->bghcn', qc, k_cmp) * scale
        p_cmp = masked_softmax(s, cmp_last[None, :] <= tq[:, None])
        o_cmp = jnp.einsum('bghcn,bngd->bcghd', p_cmp.astype(v_cmp.dtype), v_cmp)
        imp = jnp.einsum('bghcn,nj->bgcj', p_cmp, overlap)
        cur = tq[:, None] // SEL_BLOCK
        forced = (blk_ids[None] == 0) | (blk_ids[None] == cur) | (blk_ids[None] == cur - 1)
        imp = jnp.where(forced, 1e4, jnp.where(blk_ids[None] <= cur, imp, -1.0))
        _, sel = lax.top_k(imp, top_k)
        kb = ks_blk[b_ix, g_ix, sel]
        vb = vs_blk[b_ix, g_ix, sel]
        s = jnp.einsum('bcghd,bgcksd->bghcks', qr, kb) * scale
        key_pos = sel[..., None] * SEL_BLOCK + jnp.arange(SEL_BLOCK)
        mask = (key_pos <= tq[None, None, :, None, None]).reshape(B, G, 1, Q_CHUNK, top_k * SEL_BLOCK)
        p = masked_softmax(s.reshape(B, G, HPG, Q_CHUNK, top_k * SEL_BLOCK), mask)
        o_sel = jnp.einsum('bghcks,bgcksd->bcghd', p.reshape(s.shape).astype(vb.dtype), vb)
        kwc = lax.dynamic_slice_in_dim(kw_pad, t0, span, axis=1)
        vwc = lax.dynamic_slice_in_dim(vw_pad, t0, span, axis=1)
        kpos = t0 - WINDOW + jnp.arange(span)
        wmask = (kpos[None] <= tq[:, None]) & (kpos[None] > tq[:, None] - WINDOW) & (kpos[None] >= 0)
        s = jnp.einsum('bcghd,bsgd->bghcs', qr, kwc) * scale
        p = masked_softmax(s, wmask)
        o_win = jnp.einsum('bghcs,bsgd->bcghd', p.astype(vwc.dtype), vwc)
        return o_cmp, o_sel, o_win

    outs = lax.map(chunk, jnp.arange(T // Q_CHUNK))
    o_cmp, o_sel, o_win = (jnp.moveaxis(o, 0, 1).reshape(B, T, NSA_HEADS, D) for o in outs)
    gates = jax.nn.sigmoid(gate_logits.astype(jnp.float32)).reshape(B, T, NSA_HEADS, 3)
    o = gates[..., 0:1] * o_cmp + gates[..., 1:2] * o_sel + gates[..., 2:3] * o_win
    return o.reshape(B, T, NSA_WIDTH).astype(q.dtype)


def hybrid_mixer(h_n, w_in, shift_mu, rw_w_up, rw_w0, rw_a_up, rw_a0, rw_g_up, rw_k_k, rw_k_a,
                 rw_r_k, rw_ln_g, rw_ln_b, nsa_pe_k, nsa_pe_v, nsa_ck1, nsa_ck2, nsa_cv1, nsa_cv2,
                 w_up_rw, w_up_nsa, w_out):
    p = h_n @ w_in
    p_rw, q, kc, vc, ks, vs, kw, vw, g_nsa, g_merge = split_cols(p, IN_SIZES)
    p_rw = token_shift(p_rw, shift_mu)
    y_rw = rwkv7_time_mix(p_rw, rw_w_up, rw_w0, rw_a_up, rw_a0, rw_g_up, rw_k_k, rw_k_a,
                          rw_r_k, rw_ln_g, rw_ln_b) @ w_up_rw
    y_nsa = nsa_attention(q, kc, vc, ks, vs, kw, vw, g_nsa, nsa_pe_k, nsa_pe_v,
                          nsa_ck1, nsa_ck2, nsa_cv1, nsa_cv2) @ w_up_nsa
    g_rw, g_ns = jnp.split(jax.nn.sigmoid(g_merge), 2, axis=-1)
    return (g_rw * y_rw + g_ns * y_nsa) @ w_out


def memory_cross_attention(h_n, mem_n, wq, wkv, wo):
    B, T, _ = h_n.shape
    M = mem_n.shape[1]
    q = (h_n @ wq).reshape(B, T, XA_HEADS, XA_HEAD_DIM)
    k, v = jnp.split(mem_n @ wkv, 2, axis=-1)
    k = k.reshape(B, M, XA_HEADS, XA_HEAD_DIM)
    v = v.reshape(B, M, XA_HEADS, XA_HEAD_DIM)
    s = jnp.einsum('bthd,bmhd->bhtm', q, k).astype(jnp.float32) * (XA_HEAD_DIM ** -0.5)
    p = jax.nn.softmax(s, axis=-1)
    o = jnp.einsum('bhtm,bmhd->bthd', p.astype(v.dtype), v).reshape(B, T, D_MODEL)
    return o @ wo


def swiglu_ffn(h_n, w_gu, w_down):
    g, u = jnp.split(h_n @ w_gu, 2, axis=-1)
    return (jax.nn.silu(g) * u) @ w_down


def setup_inputs(seed: int = 0) -> dict:
    key = jax.random.key(seed)
    keys = iter(jax.random.split(key, 40))
    L = (DEPTH,)

    def nrm(shape, scale):
        return jax.random.normal(next(keys), shape, jnp.float32) * scale

    def gain(n):
        return 1.0 + nrm(L + (n,), 0.02)

    inputs = {}
    inputs['x'] = nrm((BATCH, SEQ, D_MODEL), 1.0)
    inputs['mem'] = nrm((BATCH, N_MEM, D_MODEL), 1.0)
    inputs['norm_mix_g'] = gain(D_MODEL)
    inputs['w_in'] = nrm(L + (D_MODEL, D_IN), D_MODEL ** -0.5)
    inputs['shift_mu'] = jax.random.uniform(next(keys), L + (RW_IN,), jnp.float32)
    inputs['rw_w_up'] = nrm(L + (DECAY_LORA, RW_WIDTH), 0.5 * DECAY_LORA ** -0.5)
    inputs['rw_w0'] = -2.0 + nrm(L + (RW_WIDTH,), 0.5)
    inputs['rw_a_up'] = nrm(L + (AAA_LORA, RW_WIDTH), AAA_LORA ** -0.5)
    inputs['rw_a0'] = nrm(L + (RW_WIDTH,), 0.5)
    inputs['rw_g_up'] = nrm(L + (GATE_LORA, RW_WIDTH), GATE_LORA ** -0.5)
    inputs['rw_k_k'] = 0.85 + nrm(L + (RW_WIDTH,), 0.05)
    inputs['rw_k_a'] = 1.0 + nrm(L + (RW_WIDTH,), 0.05)
    inputs['rw_r_k'] = nrm(L + (RW_HEADS, HEAD_DIM), 0.1)
    inputs['rw_ln_g'] = gain(RW_WIDTH)
    inputs['rw_ln_b'] = nrm(L + (RW_WIDTH,), 0.02)
    inputs['nsa_pe_k'] = nrm(L + (CMP_BLOCK, HEAD_DIM), 0.02)
    inputs['nsa_pe_v'] = nrm(L + (CMP_BLOCK, HEAD_DIM), 0.02)
    inputs['nsa_ck1'] = nrm(L + (CMP_BLOCK * HEAD_DIM, CMP_HIDDEN), (CMP_BLOCK * HEAD_DIM) ** -0.5)
    inputs['nsa_ck2'] = nrm(L + (CMP_HIDDEN, HEAD_DIM), CMP_HIDDEN ** -0.5)
    inputs['nsa_cv1'] = nrm(L + (CMP_BLOCK * HEAD_DIM, CMP_HIDDEN), (CMP_BLOCK * HEAD_DIM) ** -0.5)
    inputs['nsa_cv2'] = nrm(L + (CMP_HIDDEN, HEAD_DIM), CMP_HIDDEN ** -0.5)
    inputs['w_up_rw'] = nrm(L + (RW_WIDTH, D_MODEL), RW_WIDTH ** -0.5)
    inputs['w_up_nsa'] = nrm(L + (NSA_WIDTH, D_MODEL), NSA_WIDTH ** -0.5)
    inputs['w_out'] = nrm(L + (D_MODEL, D_MODEL), D_MODEL ** -0.5)
    inputs['norm_xa_g'] = gain(D_MODEL)
    inputs['norm_mem_g'] = gain(D_MODEL)
    inputs['xa_wq'] = nrm(L + (D_MODEL, D_MODEL), D_MODEL ** -0.5)
    inputs['xa_wkv'] = nrm(L + (D_MODEL, 2 * D_MODEL), D_MODEL ** -0.5)
    inputs['xa_wo'] = nrm(L + (D_MODEL, D_MODEL), D_MODEL ** -0.5)
    inputs['norm_ffn_g'] = gain(D_MODEL)
    inputs['ffn_w_gu'] = nrm(L + (D_MODEL, 2 * D_FF), D_MODEL ** -0.5)
    inputs['ffn_w_down'] = nrm(L + (D_FF, D_MODEL), D_FF ** -0.5)
    inputs['final_norm_g'] = 1.0 + nrm((D_MODEL,), 0.02)
    return inputs


def reference(x, mem, norm_mix_g, w_in, shift_mu, rw_w_up, rw_w0, rw_a_up, rw_a0, rw_g_up,
              rw_k_k, rw_k_a, rw_r_k, rw_ln_g, rw_ln_b, nsa_pe_k, nsa_pe_v, nsa_ck1, nsa_ck2,
              nsa_cv1, nsa_cv2, w_up_rw, w_up_nsa, w_out, norm_xa_g, norm_mem_g, xa_wq, xa_wkv,
              xa_wo, norm_ffn_g, ffn_w_gu, ffn_w_down, final_norm_g):
    h = x
    for l in range(DEPTH):
        h = h + hybrid_mixer(rms_norm(h, norm_mix_g[l]), w_in[l], shift_mu[l], rw_w_up[l], rw_w0[l],
                             rw_a_up[l], rw_a0[l], rw_g_up[l], rw_k_k[l], rw_k_a[l], rw_r_k[l],
                             rw_ln_g[l], rw_ln_b[l], nsa_pe_k[l], nsa_pe_v[l], nsa_ck1[l], nsa_ck2[l],
                             nsa_cv1[l], nsa_cv2[l], w_up_rw[l], w_up_nsa[l], w_out[l])
        h = h + memory_cross_attention(rms_norm(h, norm_xa_g[l]), rms_norm(mem, norm_mem_g[l]),
                                       xa_wq[l], xa_wkv[l], xa_wo[l])
        h = h + swiglu_ffn(rms_norm(h, norm_ffn_g[l]), ffn_w_gu[l], ffn_w_down[l])
    return rms_norm(h, final_norm_g)
```

```cpp
#include <hip/hip_runtime.h>
#include <hip/hip_cooperative_groups.h>
#include <cstdio>
#include <cstdint>
namespace cg = cooperative_groups;
namespace pg8 {
#define PG8_LAS __attribute__((address_space(3)))
typedef unsigned short bf16_t;
typedef short bf16x8 __attribute__((ext_vector_type(8)));
typedef float f32x4 __attribute__((ext_vector_type(4)));
typedef unsigned u32x4 __attribute__((ext_vector_type(4)));
constexpr int BM = 256, BK = 64, HALF = 128, HTB = HALF * BK * 2  , STAGE_BYTES = 8 * HTB, NXCD = 8, WGM = 8;

__host__ __device__ __forceinline__ int lds_byte(int r, int c) { const int st = (r >> 4) * 2 + (c >> 5), rr = r & 15, cc = c & 31, ob = rr * 64 + cc * 2; return st * 1024 + (ob ^ (((ob >> 9) & 1) << 5)); }
__host__ __device__ __forceinline__ void stage_rc(int b, int& R, int& C) { const int st = b / 1024, sb = b % 1024, swz = sb ^ (((sb >> 9) & 1) << 5); R = (st >> 1) * 16 + swz / 64; C = (st & 1) * 32 + (swz % 64) / 2; }
__host__ __device__ __forceinline__ int perm32(int rho) { const int n = rho >> 4, i = rho & 15; return 8 * (i >> 2) + 4 * n + (i & 3); }

struct Unit { int pm, pn; };
struct Gemm { const bf16_t* A; const bf16_t* Bt; int M, N, K; };

struct StaticOrder {
    int nM, nN, nwg, G, c;
    __host__ __device__ void init(int M, int N, int G_, int c_) { nM = M / BM; nN = N / BM; nwg = nM * nN; G = G_; c = c_; }
    __host__ __device__ bool next(int i, Unit& u) const {
        const long L = (long)i * G + c; if (L >= nwg) return false;
        int wgid = (int)L; { const int q = nwg / NXCD, r = nwg % NXCD, xcd = wgid % NXCD, off = wgid / NXCD; wgid = (xcd < r ? xcd * (q + 1) : r * (q + 1) + (xcd - r) * q) + off; }
        const int nig = WGM * nN, gid = wgid / nig, fm = gid * WGM, gsz = (nM - fm) < WGM ? (nM - fm) : WGM;
        u.pm = fm + ((wgid % nig) % gsz); u.pn = (wgid % nig) / gsz; return true;
    }
    __device__ __forceinline__ void a_ready(const Unit&) const {}
    __device__ __forceinline__ void done(const Unit&) const {}
};
template <class Epi, class Sched, bool ALIGN_EPI = false, bool SP2 = false>
__device__ __forceinline__ void gemm_phase(PG8_LAS unsigned char* lds, const Gemm g, const Sched& S, const Epi& E) {
    const int tid = threadIdx.x, wid = __builtin_amdgcn_readfirstlane(tid >> 6), lane = tid & 63, wr = wid >> 2, wc = wid & 3, fr = lane & 15, fq = lane >> 4;
    const int K = g.K, nt = K / BK;
    unsigned voffA[2], voffB[2];
#pragma unroll
    for (int i = 0; i < 2; ++i) { int R, C; stage_rc(tid * 16 + i * 8192, R, C); const int Rb = Epi::PERM ? ((R & ~31) + perm32(R & 31)) : R;
        voffA[i] = (unsigned)(R * K + C) * 2u; voffB[i] = (unsigned)(Rb * K + C) * 2u; }
    const size_t kstep = (size_t)(BK * 2);
    const size_t hstep = (size_t)HALF * K * 2;
    const size_t tstep = 2 * hstep;
    const unsigned ldsw = (unsigned)wid * 1024u;
    const int aoff = lds_byte(wr * 64 + fr, fq * 8), boff = lds_byte(wc * 32 + fr, fq * 8);
#define PG8_SA(b, h) (((b) * 2 + (h)) * HTB)
#define PG8_SB(b, h) ((4 + (b) * 2 + (h)) * HTB)
#define PG8_STAGE(bufoff, gbase, voff) do { _Pragma("unroll") for (int _i = 0; _i < 2; ++_i) \
        __builtin_amdgcn_global_load_lds((const unsigned*)((const char*)(gbase) + (voff)[_i]), (PG8_LAS unsigned*)(lds + (bufoff) + ldsw + _i * 8192), 16, 0, 0); } while (0)
#define PG8_LDA(dst, b, h) do { _Pragma("unroll") for (int m = 0; m < 4; ++m) _Pragma("unroll") for (int k = 0; k < 2; ++k) dst[m][k] = *(const PG8_LAS bf16x8*)(lds + PG8_SA(b, h) + aoff + m * 2048 + k * 1024); } while (0)
#define PG8_LDB(dst, b, h) do { _Pragma("unroll") for (int n = 0; n < 2; ++n) _Pragma("unroll") for (int k = 0; k < 2; ++k) dst[n][k] = *(const PG8_LAS bf16x8*)(lds + PG8_SB(b, h) + boff + n * 2048 + k * 1024); } while (0)
#define PG8_MMA(ai, bj, At, Bt) do { __builtin_amdgcn_s_setprio(1); _Pragma("unroll") for (int m = 0; m < 4; ++m) _Pragma("unroll") for (int n = 0; n < 2; ++n) _Pragma("unroll") for (int k = 0; k < 2; ++k) \
        acc[ai][bj][m][n] = __builtin_amdgcn_mfma_f32_16x16x32_bf16(Bt[n][k], At[m][k], acc[ai][bj][m][n], 0, 0, 0); __builtin_amdgcn_s_setprio(0); } while (0)
#define PG8_WAIT_V(n) asm volatile("s_waitcnt vmcnt(" #n ")" ::: "memory")
#define PG8_WAIT_L(n) asm volatile("s_waitcnt lgkmcnt(" #n ")" ::: "memory")
#define PG8_BAR __builtin_amdgcn_s_barrier()
#define PG8_SCHED __builtin_amdgcn_sched_barrier(0)
    Unit cur, nxt; int ui = 0;
    if (!S.next(0, cur)) return;
    f32x4 acc[2][2][4][2];
#pragma unroll
    for (int a = 0; a < 2; ++a)
#pragma unroll
        for (int b = 0; b < 2; ++b)
#pragma unroll
            for (int m = 0; m < 4; ++m)
#pragma unroll
                for (int n = 0; n < 2; ++n) acc[a][b][m][n] = (f32x4){0.f, 0.f, 0.f, 0.f};
    bf16x8 At[4][2], B0[2][2], B1[2][2];
    const char* cA = (const char*)g.A + (size_t)cur.pm * tstep; const char* cB = (const char*)g.Bt + (size_t)cur.pn * tstep;
    S.a_ready(cur);
    if constexpr (SP2) {
        PG8_STAGE(PG8_SB(0, 0), cB, voffB); PG8_STAGE(PG8_SB(0, 1), cB + hstep, voffB); PG8_STAGE(PG8_SA(0, 0), cA, voffA); PG8_STAGE(PG8_SA(0, 1), cA + hstep, voffA);
        if (wr == 1) PG8_BAR;
        PG8_WAIT_V(2); PG8_BAR;
        PG8_STAGE(PG8_SB(1, 0), cB + kstep, voffB); PG8_STAGE(PG8_SA(1, 0), cA + kstep, voffA); PG8_STAGE(PG8_SB(1, 1), cB + hstep + kstep, voffB);
        PG8_WAIT_V(6); PG8_BAR;
    } else {
        PG8_STAGE(PG8_SB(0, 0), cB, voffB); PG8_STAGE(PG8_SA(0, 0), cA, voffA); PG8_STAGE(PG8_SB(0, 1), cB + hstep, voffB); PG8_STAGE(PG8_SA(0, 1), cA + hstep, voffA);
        if (wr == 1) PG8_BAR;
        PG8_WAIT_V(4); PG8_BAR;
        PG8_STAGE(PG8_SB(1, 0), cB + kstep, voffB); PG8_STAGE(PG8_SA(1, 0), cA + kstep, voffA); PG8_STAGE(PG8_SB(1, 1), cB + hstep + kstep, voffB);
        PG8_WAIT_V(6); PG8_BAR;
    }
    for (;;) {
        const bool has_next = S.next(ui + 1, nxt);
        const char* nA = has_next ? (const char*)g.A + (size_t)nxt.pm * tstep : cA; const char* nB = has_next ? (const char*)g.Bt + (size_t)nxt.pn * tstep : cB;
        for (int t = 0; t < nt; t += 2) {
            const bool last = (t == nt - 2);
            const char* a1 = cA + (size_t)(t + 1) * kstep;
            const char* a2 = last ? nA : cA + (size_t)(t + 2) * kstep; const char* b2 = last ? nB : cB + (size_t)(t + 2) * kstep;
            const char* a3 = a2 + kstep; const char* b3 = b2 + kstep;
            if (last && has_next) S.a_ready(nxt);
            if constexpr (SP2) {
            PG8_LDB(B0, 0, 0); PG8_LDB(B1, 0, 1); PG8_SCHED; PG8_LDA(At, 0, 0); PG8_STAGE(PG8_SA(1, 1), a1 + hstep, voffA);
            PG8_WAIT_V(8); PG8_WAIT_L(0); PG8_BAR; PG8_MMA(0, 0, At, B0); PG8_MMA(0, 1, At, B1); PG8_BAR; PG8_SCHED;
            PG8_LDA(At, 0, 1); PG8_STAGE(PG8_SB(0, 0), b2, voffB); PG8_STAGE(PG8_SB(0, 1), b2 + hstep, voffB); PG8_STAGE(PG8_SA(0, 0), a2, voffA);
            PG8_WAIT_V(8); PG8_WAIT_L(0); PG8_BAR; PG8_MMA(1, 0, At, B0); PG8_MMA(1, 1, At, B1); PG8_BAR; PG8_SCHED;
            PG8_LDB(B0, 1, 0); PG8_LDB(B1, 1, 1); PG8_SCHED; PG8_LDA(At, 1, 0); PG8_STAGE(PG8_SA(0, 1), a2 + hstep, voffA);
            PG8_WAIT_V(8); PG8_WAIT_L(0); PG8_BAR; PG8_MMA(0, 0, At, B0); PG8_MMA(0, 1, At, B1); PG8_BAR; PG8_SCHED;
            PG8_LDA(At, 1, 1); PG8_STAGE(PG8_SB(1, 0), b3, voffB); PG8_STAGE(PG8_SB(1, 1), b3 + hstep, voffB); PG8_STAGE(PG8_SA(1, 0), a3, voffA);
            PG8_WAIT_V(8); PG8_WAIT_L(0); PG8_BAR; PG8_MMA(1, 0, At, B0); PG8_MMA(1, 1, At, B1); PG8_BAR; PG8_SCHED;
            } else {
            PG8_LDB(B0, 0, 0); PG8_SCHED; PG8_LDA(At, 0, 0); PG8_STAGE(PG8_SA(1, 1), a1 + hstep, voffA);
            PG8_WAIT_L(8); PG8_BAR; PG8_WAIT_L(0); PG8_MMA(0, 0, At, B0); PG8_BAR; PG8_SCHED;
            PG8_LDB(B1, 0, 1); PG8_STAGE(PG8_SB(0, 0), b2, voffB);
            PG8_BAR; PG8_WAIT_L(0); PG8_MMA(0, 1, At, B1); PG8_BAR;
            PG8_LDA(At, 0, 1); PG8_STAGE(PG8_SA(0, 0), a2, voffA);
            PG8_BAR; PG8_WAIT_L(0); PG8_MMA(1, 0, At, B0); PG8_BAR; PG8_SCHED;
            PG8_STAGE(PG8_SB(0, 1), b2 + hstep, voffB);
            PG8_WAIT_V(6); PG8_BAR; PG8_MMA(1, 1, At, B1); PG8_BAR;
            PG8_LDB(B0, 1, 0); PG8_SCHED; PG8_LDA(At, 1, 0); PG8_STAGE(PG8_SA(0, 1), a2 + hstep, voffA);
            PG8_WAIT_L(8); PG8_BAR; PG8_WAIT_L(0); PG8_MMA(0, 0, At, B0); PG8_BAR; PG8_SCHED;
            PG8_LDB(B1, 1, 1); PG8_STAGE(PG8_SB(1, 0), b3, voffB);
            PG8_BAR; PG8_WAIT_L(0); PG8_MMA(0, 1, At, B1); PG8_BAR;
            PG8_LDA(At, 1, 1); PG8_STAGE(PG8_SA(1, 0), a3, voffA);
            PG8_BAR; PG8_WAIT_L(0); PG8_MMA(1, 0, At, B0); PG8_BAR; PG8_SCHED;
            PG8_STAGE(PG8_SB(1, 1), b3 + hstep, voffB);
            PG8_WAIT_V(6); PG8_BAR; PG8_MMA(1, 1, At, B1); PG8_BAR;
            }
        }
        if constexpr (ALIGN_EPI) { if (wr == 0) PG8_BAR; }
        if constexpr (!Epi::AFTER_DRAIN) { E(acc, cur, wr, wc, fr, fq); S.done(cur); }
        if (!has_next) break;
#pragma unroll
        for (int a = 0; a < 2; ++a)
#pragma unroll
            for (int b = 0; b < 2; ++b)
#pragma unroll
                for (int m = 0; m < 4; ++m)
#pragma unroll
                    for (int n = 0; n < 2; ++n) acc[a][b][m][n] = (f32x4){0.f, 0.f, 0.f, 0.f};
        cur = nxt; cA = nA; cB = nB; ++ui;
        if constexpr (ALIGN_EPI) { if (wr == 1) PG8_BAR; }
    }
    PG8_WAIT_V(0);
    if constexpr (!ALIGN_EPI) { if (wr == 0) PG8_BAR; }
    PG8_BAR;
    if constexpr (Epi::AFTER_DRAIN) { E.fused(acc, cur, wr, wc, fr, fq, lds, wid, lane); S.done(cur); }
#undef PG8_SA
#undef PG8_SB
#undef PG8_STAGE
#undef PG8_LDA
#undef PG8_LDB
#undef PG8_MMA
#undef PG8_WAIT_V
#undef PG8_WAIT_L
#undef PG8_BAR
#undef PG8_SCHED
}
}

#define LAS __attribute__((address_space(3)))
typedef unsigned short bf16_t;
typedef short bf16x8 __attribute__((ext_vector_type(8)));
typedef float f32x4 __attribute__((ext_vector_type(4)));
typedef float f32x2 __attribute__((ext_vector_type(2)));
typedef unsigned u32x4 __attribute__((ext_vector_type(4)));
typedef unsigned u32x2 __attribute__((ext_vector_type(2)));

constexpr int BATCH = 16, SEQ = 2048, DM = 1024, MTOK = BATCH * SEQ, NMEM = 256, DFF = 2816;
constexpr int NIN = 5376;
constexpr size_t MiB = 1u << 20;
constexpr size_t WS_WIN = 1 * MiB, WS_WUPRW = 12 * MiB, WS_WUPNSA = 13 * MiB, WS_WOUT = 14 * MiB, WS_WQ = 16 * MiB, WS_WKV = 18 * MiB, WS_WO = 22 * MiB,
                 WS_WGU = 24 * MiB, WS_WDOWN = 35 * MiB, WS_LORA_W = 41 * MiB, WS_LORA_A = 41 * MiB + 65536, WS_LORA_G = 41 * MiB + 131072,
                 WS_CK1T = 42 * MiB, WS_CV1T = 42 * MiB + 524288, WS_CK2T = 43 * MiB, WS_CV2T = 43 * MiB + 16384, WS_ROPE = 44 * MiB,
                 WS_KCMP = 45 * MiB, WS_VCMPT = 45 * MiB + 524288, WS_SELM = 46 * MiB,
                 WS_XN = 48 * MiB, WS_PRW = 112 * MiB, WS_Q = 224 * MiB, WS_KV6 = 256 * MiB, WS_GN = 304 * MiB, WS_GM = 306 * MiB,
                 WS_VST = 434 * MiB, WS_VWT = 442 * MiB, WS_MEMN = 450 * MiB, WS_KX = 458 * MiB, WS_VXT = 466 * MiB, WS_G = 477 * MiB,
                 WS_SKK = 48 * MiB, WS_SKKA = 80 * MiB, WS_Y = 112 * MiB, WS_ONSA = 144 * MiB, WS_T1 = 48 * MiB, WS_XN2 = 112 * MiB,
                 WS_QX = 176 * MiB, WS_OX = 48 * MiB, WS_HFF = 176 * MiB, WS_SSQ = 509 * MiB, WS_NEED = 512 * MiB;
constexpr size_t DO_SR = 0, DO_SLD = 32 * MiB, DO_SK = 64 * MiB, DO_SV = 96 * MiB;
constexpr int LDS_BYTES = 147456;

struct Prm { const float* in[33]; float* out; unsigned char* ws; };

__device__ __forceinline__ float bf_lo(unsigned u) { return __uint_as_float(u << 16); }
__device__ __forceinline__ float bf_hi(unsigned u) { return __uint_as_float(u & 0xffff0000u); }
__device__ __forceinline__ float bf1(bf16_t v) { return __uint_as_float((unsigned)v << 16); }
__device__ __forceinline__ unsigned f2bf(float f) { unsigned u = __float_as_uint(f); return (u + 0x7fffu + ((u >> 16) & 1u)) >> 16; }
typedef __bf16 bf16x2_hw __attribute__((ext_vector_type(2)));
__device__ __forceinline__ unsigned pk2(float lo, float hi) { const f32x2 v = {lo, hi}; return __builtin_bit_cast(unsigned, __builtin_convertvector(v, bf16x2_hw)); }
__device__ __forceinline__ u32x4 ld16(const void* p) { return *(const u32x4*)p; }
__device__ __forceinline__ u32x2 ld8(const void* p) { return *(const u32x2*)p; }
__device__ __forceinline__ void unpack8(u32x4 v, float (&f)[8]) { f[0] = bf_lo(v.x); f[1] = bf_hi(v.x); f[2] = bf_lo(v.y); f[3] = bf_hi(v.y); f[4] = bf_lo(v.z); f[5] = bf_hi(v.z); f[6] = bf_lo(v.w); f[7] = bf_hi(v.w); }
__device__ __forceinline__ void unpack4(u32x2 v, float (&f)[4]) { f[0] = bf_lo(v.x); f[1] = bf_hi(v.x); f[2] = bf_lo(v.y); f[3] = bf_hi(v.y); }
__device__ __forceinline__ bf16x8 pack8(const float (&f)[8]) { u32x4 v; v.x = pk2(f[0], f[1]); v.y = pk2(f[2], f[3]); v.z = pk2(f[4], f[5]); v.w = pk2(f[6], f[7]); return __builtin_bit_cast(bf16x8, v); }
__device__ __forceinline__ u32x2 pack4(float a, float b, float c, float d) { u32x2 v; v.x = pk2(a, b); v.y = pk2(c, d); return v; }
__device__ __forceinline__ bf16x8 frag_from(u32x4 v) { return __builtin_bit_cast(bf16x8, v); }
__device__ __forceinline__ bf16x8 frag_from2(u32x2 lo, u32x2 hi) { u32x4 v; v.x = lo.x; v.y = lo.y; v.z = hi.x; v.w = hi.y; return __builtin_bit_cast(bf16x8, v); }
__device__ __forceinline__ bf16x8 frag_pk(f32x4 a, f32x4 b) { u32x4 v; v.x = pk2(a[0], a[1]); v.y = pk2(a[2], a[3]); v.z = pk2(b[0], b[1]); v.w = pk2(b[2], b[3]); return __builtin_bit_cast(bf16x8, v); }
__device__ __forceinline__ float qmax(float x) {
    auto a = __builtin_amdgcn_permlane16_swap(__float_as_uint(x), __float_as_uint(x), false, false); x = fmaxf(__uint_as_float(a[0]), __uint_as_float(a[1]));
    auto b = __builtin_amdgcn_permlane32_swap(__float_as_uint(x), __float_as_uint(x), false, false); return fmaxf(__uint_as_float(b[0]), __uint_as_float(b[1]));
}
__device__ __forceinline__ float qsum(float x) {
    auto a = __builtin_amdgcn_permlane16_swap(__float_as_uint(x), __float_as_uint(x), false, false); x = __uint_as_float(a[0]) + __uint_as_float(a[1]);
    auto b = __builtin_amdgcn_permlane32_swap(__float_as_uint(x), __float_as_uint(x), false, false); return __uint_as_float(b[0]) + __uint_as_float(b[1]);
}
#define MFMA16(a, b, c) __builtin_amdgcn_mfma_f32_16x16x32_bf16((a), (b), (c), 0, 0, 0)
__device__ __forceinline__ float sigm(float x) { return __builtin_amdgcn_rcpf(1.0f + __expf(-x)); }
__device__ __forceinline__ float tanh_f(float x) { const float e = __expf(2.0f * x); return 1.0f - 2.0f * __builtin_amdgcn_rcpf(e + 1.0f); }
__device__ __forceinline__ float wave_sum(float v) {
#pragma unroll
    for (int o = 1; o < 64; o <<= 1) v += __shfl_xor(v, o);
    return v;
}
template <int CTRL> __device__ __forceinline__ float dpp_mov(float x) { return __int_as_float(__builtin_amdgcn_update_dpp(0, __float_as_int(x), CTRL, 0xf, 0xf, true)); }
__device__ __forceinline__ float red16(float x) {
    x += dpp_mov<0xB1>(x); x += dpp_mov<0x4E>(x); x += dpp_mov<0x141>(x); x += dpp_mov<0x140>(x); return x;
}

__device__ __forceinline__ void red16_pair(float a, float b, bool odd, float& ra, float& rb) {
    const float keep = odd ? b : a, give = odd ? a : b;
    float q = keep + dpp_mov<0xB1>(give);
    q += dpp_mov<0x4E>(q);
    q += dpp_mov<0x124>(q);
    q += dpp_mov<0x128>(q);
    ra = dpp_mov<0x00>(q);
    rb = dpp_mov<0x55>(q);
}
__device__ __forceinline__ float red16_pair_nb(float a, float b, bool odd) {
    const float keep = odd ? b : a, give = odd ? a : b;
    float q = keep + dpp_mov<0xB1>(give); q += dpp_mov<0x4E>(q); q += dpp_mov<0x124>(q); q += dpp_mov<0x128>(q); return q;
}
#define EPI_LOOP(...) _Pragma("unroll") for (int ai = 0; ai < 2; ++ai) _Pragma("unroll") for (int m = 0; m < 4; ++m) { const int row = u.pm * 256 + ai * 128 + wr * 64 + m * 16 + fr; \
    _Pragma("unroll") for (int bj = 0; bj < 2; ++bj) _Pragma("unroll") for (int n = 0; n < 2; ++n) { const int lc = bj * 128 + wc * 32 + 8 * fq + 4 * n; const f32x4 a = acc[ai][bj][m][n]; __VA_ARGS__ } }

#define EPI2_LOOP(...) _Pragma("unroll") for (int ai = 0; ai < 2; ++ai) _Pragma("unroll") for (int m = 0; m < 4; ++m) { const int row = u.pm * 256 + ai * 128 + wr * 64 + m * 16 + fr; \
    _Pragma("unroll") for (int bj = 0; bj < 2; ++bj) { const int lc = bj * 128 + wc * 32 + 8 * fq; const f32x4 a0 = acc[ai][bj][m][0], a1 = acc[ai][bj][m][1]; __VA_ARGS__ } }
__device__ __forceinline__ u32x4 pack8v(f32x4 a, f32x4 b) { u32x4 v; v.x = pk2(a[0], a[1]); v.y = pk2(a[2], a[3]); v.z = pk2(b[0], b[1]); v.w = pk2(b[2], b[3]); return v; }
__device__ __forceinline__ f32x4 sigm4(f32x4 v) { return (f32x4){sigm(v[0]), sigm(v[1]), sigm(v[2]), sigm(v[3])}; }
struct EpiInProj {
    static constexpr bool PERM = true, AFTER_DRAIN = false;
    bf16_t *prw, *q, *kv6, *gm, *gn;
    __device__ __forceinline__ void operator()(const f32x4 (&acc)[2][2][4][2], const pg8::Unit& u, int wr, int wc, int fr, int fq) const {
        bf16_t* base; int pitch, c0; bool sg = false;
        const int pn = u.pn;
        if (pn < 7) { base = prw; pitch = 1792; c0 = pn * 256; }
        else if (pn < 9) { base = q; pitch = 512; c0 = (pn - 7) * 256; }
        else if (pn < 12) { base = kv6; pitch = 768; c0 = (pn - 9) * 256; }
        else if (pn < 20) { base = gm; pitch = 2048; c0 = (pn - 12) * 256; sg = true; }
        else { base = gn; pitch = 32; c0 = 0; sg = true; }
        EPI2_LOOP({
            if (pn < 20 || lc < 32) { *(u32x4*)(base + (size_t)row * pitch + c0 + lc) = sg ? pack8v(sigm4(a0), sigm4(a1)) : pack8v(a0, a1); }
        })
    }
};
struct EpiBf16 {
    static constexpr bool PERM = true, AFTER_DRAIN = false;
    bf16_t* o; int pitch;
    __device__ __forceinline__ void operator()(const f32x4 (&acc)[2][2][4][2], const pg8::Unit& u, int wr, int wc, int fr, int fq) const {
        EPI_LOOP({ *(u32x2*)(o + (size_t)row * pitch + u.pn * 256 + lc) = pack4(a[0], a[1], a[2], a[3]); })
    }
};
struct EpiMemK {
    static constexpr bool PERM = true, AFTER_DRAIN = false;
    bf16_t* kx;
    __device__ __forceinline__ void operator()(const f32x4 (&acc)[2][2][4][2], const pg8::Unit& u, int wr, int wc, int fr, int fq) const {
        EPI2_LOOP({ *(u32x4*)(kx + (size_t)row * 1024 + u.pn * 256 + lc) = pack8v(a0, a1); })
    }
};
struct EpiMemVT {
    static constexpr bool PERM = true, AFTER_DRAIN = false;
    bf16_t* vxt;
    __device__ __forceinline__ void operator()(const f32x4 (&acc)[2][2][4][2], const pg8::Unit& u, int wr, int wc, int fr, int fq) const {
        bf16_t* base = vxt + (size_t)(u.pn * 4 + u.pm) * 256 * 256;
#pragma unroll
        for (int ai = 0; ai < 2; ++ai)
#pragma unroll
            for (int m = 0; m < 4; ++m) { const int d = ai * 128 + wr * 64 + m * 16 + fr;
#pragma unroll
                for (int bj = 0; bj < 2; ++bj) *(u32x4*)(base + (size_t)d * 256 + bj * 128 + wc * 32 + 8 * fq) = pack8v(acc[ai][bj][m][0], acc[ai][bj][m][1]); }
    }
};
struct EpiGate1 {
    static constexpr bool PERM = true, AFTER_DRAIN = false;
    const bf16_t* gm; bf16_t* t1;
    __device__ __forceinline__ void operator()(const f32x4 (&acc)[2][2][4][2], const pg8::Unit& u, int wr, int wc, int fr, int fq) const {
        EPI2_LOOP({ const int c = u.pn * 256 + lc; float g[8]; unpack8(ld16(gm + (size_t)row * 2048 + c), g);
            *(u32x4*)(t1 + (size_t)row * 1024 + c) = pack8v((f32x4){g[0] * a0[0], g[1] * a0[1], g[2] * a0[2], g[3] * a0[3]}, (f32x4){g[4] * a1[0], g[5] * a1[1], g[6] * a1[2], g[7] * a1[3]}); })
    }
};
struct EpiGate2 {
    static constexpr bool PERM = true, AFTER_DRAIN = false;
    const bf16_t* gm; bf16_t* t1;
    __device__ __forceinline__ void operator()(const f32x4 (&acc)[2][2][4][2], const pg8::Unit& u, int wr, int wc, int fr, int fq) const {
        EPI2_LOOP({ const int c = u.pn * 256 + lc; float g[8], t[8]; unpack8(ld16(gm + (size_t)row * 2048 + 1024 + c), g); unpack8(ld16(t1 + (size_t)row * 1024 + c), t);
            *(u32x4*)(t1 + (size_t)row * 1024 + c) = pack8v((f32x4){t[0] + g[0] * a0[0], t[1] + g[1] * a0[1], t[2] + g[2] * a0[2], t[3] + g[3] * a0[3]}, (f32x4){t[4] + g[4] * a1[0], t[5] + g[5] * a1[1], t[6] + g[6] * a1[2], t[7] + g[7] * a1[3]}); })
    }
};
struct EpiResid {
    static constexpr bool PERM = true, AFTER_DRAIN = false;
    const float* res; float* out;
    __device__ __forceinline__ void operator()(const f32x4 (&acc)[2][2][4][2], const pg8::Unit& u, int wr, int wc, int fr, int fq) const {
        EPI_LOOP({ const size_t o = (size_t)row * 1024 + u.pn * 256 + lc; const f32x4 r = *(const f32x4*)(res + o); *(f32x4*)(out + o) = r + a; })
    }
};
__device__ __forceinline__ float row_rs(const float* ssq, int row) {
    const f32x4* s = (const f32x4*)(ssq + (size_t)row * 16); const f32x4 a = s[0] + s[1] + s[2] + s[3];
    return rsqrtf(((a[0] + a[1]) + (a[2] + a[3])) * (1.0f / DM) + 1e-6f);
}
__device__ __forceinline__ float row_rs_q(const float* ssq, int row, int fq) {
    const f32x4 a = ((const f32x4*)(ssq + (size_t)row * 16))[fq];
    return rsqrtf(qsum((a[0] + a[1]) + (a[2] + a[3])) * (1.0f / DM) + 1e-6f);
}
struct EpiResid2 {
    static constexpr bool PERM = true, AFTER_DRAIN = false;
    const float* res; float* out; bf16_t* hb; float* ssq;
    __device__ __forceinline__ void operator()(const f32x4 (&acc)[2][2][4][2], const pg8::Unit& u, int wr, int wc, int fr, int fq) const {
#pragma unroll
        for (int ai = 0; ai < 2; ++ai)
#pragma unroll
            for (int m = 0; m < 4; ++m) { const int row = u.pm * 256 + ai * 128 + wr * 64 + m * 16 + fr; float ss = 0.f;
#pragma unroll
                for (int bj = 0; bj < 2; ++bj)
#pragma unroll
                    for (int n = 0; n < 2; ++n) { const size_t o = (size_t)row * 1024 + u.pn * 256 + bj * 128 + wc * 32 + 8 * fq + 4 * n;
                        const f32x4 v = *(const f32x4*)(res + o) + acc[ai][bj][m][n]; *(f32x4*)(out + o) = v; *(u32x2*)(hb + o) = pack4(v[0], v[1], v[2], v[3]);
                        ss += (v[0] * v[0] + v[1] * v[1]) + (v[2] * v[2] + v[3] * v[3]); }
                ss = qsum(ss);
                if (fq == 0) ssq[(size_t)row * 16 + u.pn * 4 + wc] = ss; }
    }
};
struct EpiBf16S {
    static constexpr bool PERM = true, AFTER_DRAIN = false;
    bf16_t* o; int pitch; const float* ssq;
    __device__ __forceinline__ void operator()(const f32x4 (&acc)[2][2][4][2], const pg8::Unit& u, int wr, int wc, int fr, int fq) const {
#pragma unroll
        for (int ai = 0; ai < 2; ++ai)
#pragma unroll
            for (int m = 0; m < 4; ++m) { const int row = u.pm * 256 + ai * 128 + wr * 64 + m * 16 + fr; const float rs = row_rs_q(ssq, row, fq);
#pragma unroll
                for (int bj = 0; bj < 2; ++bj) *(u32x4*)(o + (size_t)row * pitch + u.pn * 256 + bj * 128 + wc * 32 + 8 * fq) = pack8v(acc[ai][bj][m][0] * rs, acc[ai][bj][m][1] * rs); }
    }
};
struct EpiResidH {
    static constexpr bool PERM = true, AFTER_DRAIN = false;
    const float* resf; const bf16_t* resb; bf16_t* hb; float* ssq;
    __device__ __forceinline__ void operator()(const f32x4 (&acc)[2][2][4][2], const pg8::Unit& u, int wr, int wc, int fr, int fq) const {
#pragma unroll
        for (int ai = 0; ai < 2; ++ai)
#pragma unroll
            for (int m = 0; m < 4; ++m) { const int row = u.pm * 256 + ai * 128 + wr * 64 + m * 16 + fr; float ss = 0.f;
#pragma unroll
                for (int bj = 0; bj < 2; ++bj) { const size_t o = (size_t)row * 1024 + u.pn * 256 + bj * 128 + wc * 32 + 8 * fq;
                    f32x4 r0, r1;
                    if (resf) { r0 = *(const f32x4*)(resf + o); r1 = *(const f32x4*)(resf + o + 4); }
                    else { float t[8]; unpack8(ld16(resb + o), t); r0 = (f32x4){t[0], t[1], t[2], t[3]}; r1 = (f32x4){t[4], t[5], t[6], t[7]}; }
                    const f32x4 v0 = r0 + acc[ai][bj][m][0], v1 = r1 + acc[ai][bj][m][1];
                    *(u32x4*)(hb + o) = pack8v(v0, v1);
                    ss += ((v0[0] * v0[0] + v0[1] * v0[1]) + (v0[2] * v0[2] + v0[3] * v0[3])) + ((v1[0] * v1[0] + v1[1] * v1[1]) + (v1[2] * v1[2] + v1[3] * v1[3])); }
                ss = qsum(ss);
                if (fq == 0) ssq[(size_t)row * 16 + u.pn * 4 + wc] = ss; }
    }
};
struct EpiResidB {
    static constexpr bool PERM = true, AFTER_DRAIN = false;
    const float* res; bf16_t* hb; float* ssq;
    __device__ __forceinline__ void operator()(const f32x4 (&acc)[2][2][4][2], const pg8::Unit& u, int wr, int wc, int fr, int fq) const {
#pragma unroll
        for (int ai = 0; ai < 2; ++ai)
#pragma unroll
            for (int m = 0; m < 4; ++m) { const int row = u.pm * 256 + ai * 128 + wr * 64 + m * 16 + fr; float ss = 0.f;
#pragma unroll
                for (int bj = 0; bj < 2; ++bj) { const size_t o = (size_t)row * 1024 + u.pn * 256 + bj * 128 + wc * 32 + 8 * fq;
                    const f32x4 v0 = *(const f32x4*)(res + o) + acc[ai][bj][m][0], v1 = *(const f32x4*)(res + o + 4) + acc[ai][bj][m][1];
                    *(u32x4*)(hb + o) = pack8v(v0, v1);
                    ss += ((v0[0] * v0[0] + v0[1] * v0[1]) + (v0[2] * v0[2] + v0[3] * v0[3])) + ((v1[0] * v1[0] + v1[1] * v1[1]) + (v1[2] * v1[2] + v1[3] * v1[3])); }
                ss = qsum(ss);
                if (fq == 0) ssq[(size_t)row * 16 + u.pn * 4 + wc] = ss; }
    }
};
struct EpiSwiglu {
    static constexpr bool PERM = true, AFTER_DRAIN = false;
    bf16_t* h; const float* ssq;
    __device__ __forceinline__ void operator()(const f32x4 (&acc)[2][2][4][2], const pg8::Unit& u, int wr, int wc, int fr, int fq) const {
#pragma unroll
        for (int ai = 0; ai < 2; ++ai)
#pragma unroll
            for (int m = 0; m < 4; ++m) { const int row = u.pm * 256 + ai * 128 + wr * 64 + m * 16 + fr; const float rs = row_rs_q(ssq, row, fq);
                f32x4 hv[2];
#pragma unroll
                for (int n = 0; n < 2; ++n) { const f32x4 g = acc[ai][0][m][n] * rs, uu = acc[ai][1][m][n] * rs;
                    hv[n] = (f32x4){g[0] * sigm(g[0]) * uu[0], g[1] * sigm(g[1]) * uu[1], g[2] * sigm(g[2]) * uu[2], g[3] * sigm(g[3]) * uu[3]}; }
                *(u32x4*)(h + (size_t)row * DFF + u.pn * 128 + wc * 32 + 8 * fq) = pack8v(hv[0], hv[1]); }
    }
};

template <class Epi> __device__ __forceinline__ void run_gemm(LAS unsigned char* lds, const bf16_t* A, const bf16_t* Bt, int M, int N, int K, const Epi& E, int rot = 0) {
    pg8::Gemm g{A, Bt, M, N, K}; pg8::StaticOrder S; S.init(M, N, (int)gridDim.x, (int)((blockIdx.x + rot) % gridDim.x));
    pg8::gemm_phase<Epi, pg8::StaticOrder, true, true>(lds, g, S, E);
}

__device__ __forceinline__ int rowmap(int mode, int n) {
    if (mode == 1) { if (n < 3072) return n; if (n < 3096) return 5120 + (n - 3072); return 3072 + (n - 3096); }
    if (mode == 2) { const int j = n < DFF ? n : n - DFF; return (j >> 7) * 256 + (n < DFF ? 0 : 128) + (j & 127); }
    return n;
}
__device__ __forceinline__ void transpose_w(const float* W, int K, int N, bf16_t* WT, int mode, LAS float* scr, int lane, int& off, int NGW, const float* ks = nullptr) {
    const int nblk = (N + 31) >> 5, nitems = (K >> 6) * nblk; int it = off;
    for (; it < nitems; it += NGW) {
        const int kb = it / nblk, nb = it - kb * nblk, k0 = kb * 64, n0 = nb * 32;
        float tv[32];
#pragma unroll
        for (int i = 0; i < 32; ++i) { const int kk = 2 * i + (lane >> 5), n = n0 + (lane & 31); tv[i] = (n < N) ? W[(size_t)(k0 + kk) * N + n] * (ks ? ks[k0 + kk] : 1.0f) : 0.f; }
#pragma unroll
        for (int i = 0; i < 32; ++i) { const int kk = 2 * i + (lane >> 5); scr[kk * 33 + (lane & 31)] = tv[i]; }
        asm volatile("s_waitcnt lgkmcnt(0)" ::: "memory");
        const int c = lane & 7;
#pragma unroll
        for (int j = 0; j < 4; ++j) { const int nl = (lane >> 3) + 8 * j, n = n0 + nl; const LAS float* s = scr + (8 * c) * 33 + nl;
            if (n < N) { u32x4 o; o.x = pk2(s[0], s[33]); o.y = pk2(s[66], s[99]); o.z = pk2(s[132], s[165]); o.w = pk2(s[198], s[231]);
                *(u32x4*)(WT + (size_t)rowmap(mode, n) * K + k0 + 8 * c) = o; } }
        asm volatile("s_waitcnt lgkmcnt(0)" ::: "memory");
    }
    off = it - nitems;
}
__device__ __forceinline__ void norm_rows(const float* src, const float* gain, bf16_t* dst, int rows, int lane, int gw, int NGW) {
    for (int m0 = gw; m0 < rows; m0 += 2 * NGW) {
        const int m1 = m0 + NGW; const bool h1 = m1 < rows;
        const f32x4* xa = (const f32x4*)(src + (size_t)m0 * DM) + lane; const f32x4* xb = (const f32x4*)(src + (size_t)(h1 ? m1 : m0) * DM) + lane; f32x4 va[4], vb[4]; float sa = 0.f, sb = 0.f;
#pragma unroll
        for (int j = 0; j < 4; ++j) { va[j] = xa[64 * j]; vb[j] = xb[64 * j]; }
#pragma unroll
        for (int j = 0; j < 4; ++j) { sa += (va[j][0] * va[j][0] + va[j][1] * va[j][1]) + (va[j][2] * va[j][2] + va[j][3] * va[j][3]); sb += (vb[j][0] * vb[j][0] + vb[j][1] * vb[j][1]) + (vb[j][2] * vb[j][2] + vb[j][3] * vb[j][3]); }
#pragma unroll
        for (int o = 1; o < 64; o <<= 1) { sa += __shfl_xor(sa, o); sb += __shfl_xor(sb, o); }
        const float ra = rsqrtf(sa * (1.0f / DM) + 1e-6f), rb = rsqrtf(sb * (1.0f / DM) + 1e-6f);
#pragma unroll
        for (int j = 0; j < 4; ++j) { const f32x4 g = ((const f32x4*)gain)[lane + 64 * j];
            *(u32x2*)(dst + (size_t)m0 * DM + 4 * (lane + 64 * j)) = pack4(va[j][0] * ra * g[0], va[j][1] * ra * g[1], va[j][2] * ra * g[2], va[j][3] * ra * g[3]);
            if (h1) *(u32x2*)(dst + (size_t)m1 * DM + 4 * (lane + 64 * j)) = pack4(vb[j][0] * rb * g[0], vb[j][1] * rb * g[1], vb[j][2] * rb * g[2], vb[j][3] * rb * g[3]); }
    }
}

__device__ __forceinline__ u32x4 lds_ld16(LAS unsigned char* p);
__device__ __forceinline__ void sh8(const bf16_t* cur, const bf16_t* prv, bool hp, const float* mu, int c, float (&o)[8]) {
    float a[8], b[8]; unpack8(ld16(cur + c), a); unpack8(ld16((hp ? prv : cur) + c), b);
    const f32x4 m0 = *(const f32x4*)(mu + c), m1 = *(const f32x4*)(mu + c + 4);
#pragma unroll
    for (int i = 0; i < 4; ++i) { const float b0 = hp ? b[i] : 0.f, b1 = hp ? b[4 + i] : 0.f; o[i] = a[i] + m0[i] * (b0 - a[i]); o[4 + i] = a[4 + i] + m1[i] * (b1 - a[4 + i]); }
}
__device__ __forceinline__ void sh4(const bf16_t* cur, const bf16_t* prv, bool hp, const float* mu, int c, float (&o)[4]) {
    float a[4], b[4]; unpack4(ld8(cur + c), a);
    if (hp) unpack4(ld8(prv + c), b); else { b[0] = b[1] = b[2] = b[3] = 0.f; }
    const f32x4 m0 = *(const f32x4*)(mu + c);
#pragma unroll
    for (int i = 0; i < 4; ++i) o[i] = a[i] + m0[i] * (b[i] - a[i]);
}
__device__ __forceinline__ void sh8r(u32x4 rc, u32x4 rp, bool hp, const LAS float* mul, float (&o)[8]) {
    float a[8], b[8]; unpack8(rc, a); unpack8(rp, b);
    const f32x4 m0 = *(const LAS f32x4*)(mul), m1 = *(const LAS f32x4*)(mul + 4);
#pragma unroll
    for (int i = 0; i < 4; ++i) { const float b0 = hp ? b[i] : 0.f, b1 = hp ? b[4 + i] : 0.f; o[i] = a[i] + m0[i] * (b0 - a[i]); o[4 + i] = a[4 + i] + m1[i] * (b1 - a[4 + i]); }
}
__device__ __forceinline__ void rw_prep_task(const Prm& p, LAS unsigned char* lds, int tt, int tid, int wave, int lane) {
    const int tk = lane & 15, q = lane >> 4;
    const int bt = tt * 16 + tk; const bool hp = (bt & (SEQ - 1)) > 0;
    const bf16_t* cur = (const bf16_t*)(p.ws + WS_PRW) + (size_t)bt * 1792; const bf16_t* prv = hp ? cur - 1792 : cur;
    const float* mu = p.in[4];
    const bf16_t* Ww = (const bf16_t*)(p.ws + WS_LORA_W); const bf16_t* Wa = (const bf16_t*)(p.ws + WS_LORA_A); const bf16_t* Wg = (const bf16_t*)(p.ws + WS_LORA_G);
    bf16_t* SR = (bf16_t*)((unsigned char*)p.out + DO_SR); bf16_t* SLD = (bf16_t*)((unsigned char*)p.out + DO_SLD); bf16_t* SK = (bf16_t*)((unsigned char*)p.out + DO_SK); bf16_t* SV = (bf16_t*)((unsigned char*)p.out + DO_SV);
    bf16_t* SKK = (bf16_t*)(p.ws + WS_SKK); bf16_t* SKKA = (bf16_t*)(p.ws + WS_SKKA); bf16_t* SG = (bf16_t*)(p.ws + WS_G);
    LAS float* lpar = (LAS float*)(lds + 36864); LAS float* lmu = (LAS float*)(lds + 45056); LAS unsigned char* lfr = lds + 52224 + wave * 8192 + lane * 16;
    __syncthreads();
    for (int i = tid; i < 2048; i += 512) { const int wh = i >> 9, ix = i & 511; lpar[i] = (wh == 0 ? p.in[6] : wh == 1 ? p.in[8] : wh == 2 ? p.in[10] : p.in[11])[ix]; }
    for (int i = tid; i < 1792; i += 512) lmu[i] = mu[i];
#pragma unroll
    for (int s = 0; s < 2; ++s) { float f[8]; sh8(cur, prv, hp, mu, 1536 + 32 * s + 8 * q, f);
#pragma unroll
        for (int i = 0; i < 8; ++i) f[i] = tanh_f(f[i]);
        *(LAS u32x4*)(lfr + s * 1024) = __builtin_bit_cast(u32x4, pack8(f)); }
#pragma unroll
    for (int s = 0; s < 2; ++s) { float f[8]; sh8(cur, prv, hp, mu, 1600 + 32 * s + 8 * q, f); *(LAS u32x4*)(lfr + (2 + s) * 1024) = __builtin_bit_cast(u32x4, pack8(f)); }
#pragma unroll
    for (int s = 0; s < 4; ++s) { float f[8]; sh8(cur, prv, hp, mu, 1664 + 32 * s + 8 * q, f);
#pragma unroll
        for (int i = 0; i < 8; ++i) f[i] = sigm(f[i]);
        *(LAS u32x4*)(lfr + (4 + s) * 1024) = __builtin_bit_cast(u32x4, pack8(f)); }
#pragma unroll 1
    for (int h = 0; h < 8; ++h) {
        u32x4 raw[2][6];
#pragma unroll
        for (int u = 0; u < 2; ++u) { const int c8 = h * 64 + 32 * u + 8 * q;
            raw[u][0] = ld16(cur + c8); raw[u][1] = ld16(prv + c8); raw[u][2] = ld16(cur + 512 + c8); raw[u][3] = ld16(prv + 512 + c8); raw[u][4] = ld16(cur + 1024 + c8); raw[u][5] = ld16(prv + 1024 + c8); }
        __syncthreads();
#pragma unroll
        for (int i = 0; i < 4; ++i) { const int idx = tid + 512 * i;
            if (idx < 512) *(LAS u32x4*)(lds + (idx >> 3) * 144 + (idx & 7) * 16) = ld16(Ww + (size_t)(h * 64 + (idx >> 3)) * 64 + (idx & 7) * 8);
            else if (idx < 1024) { const int j = idx - 512; *(LAS u32x4*)(lds + 9216 + (j >> 3) * 144 + (j & 7) * 16) = ld16(Wa + (size_t)(h * 64 + (j >> 3)) * 64 + (j & 7) * 8); }
            else { const int j = idx - 1024; *(LAS u32x4*)(lds + 18432 + (j >> 4) * 272 + (j & 15) * 16) = ld16(Wg + (size_t)(h * 64 + (j >> 4)) * 128 + (j & 15) * 8); } }
        __syncthreads();
        float kkr[4][4], av[4][4]; float ss = 0.f;
#define ST8(P, A, B) *(u32x4*)((P) + o) = (u32x4){pk2((A)[0], (A)[1]), pk2((A)[2], (A)[3]), pk2((B)[0], (B)[1]), pk2((B)[2], (B)[3])}
#pragma unroll
        for (int u = 0; u < 2; ++u) {
            const int c8 = h * 64 + 32 * u + 8 * q;
            float r8[8], k8[8], v8[8], kxl[8], gvl[8];
            sh8r(raw[u][0], raw[u][1], hp, lmu + c8, r8); sh8r(raw[u][2], raw[u][3], hp, lmu + 512 + c8, k8); sh8r(raw[u][4], raw[u][5], hp, lmu + 1024 + c8, v8);
#pragma unroll
            for (int e = 0; e < 2; ++e) {
                const int ct = 2 * u + e;
                const int rowl = 32 * u + 4 * e + 8 * (tk >> 2) + (tk & 3);
                f32x4 accw = {0.f, 0.f, 0.f, 0.f}, acca = {0.f, 0.f, 0.f, 0.f}, accg = {0.f, 0.f, 0.f, 0.f};
#pragma unroll
                for (int s = 0; s < 2; ++s) { accw = MFMA16(frag_from(lds_ld16(lds + rowl * 144 + 64 * s + 16 * q)), frag_from(lds_ld16(lfr + s * 1024)), accw);
                    acca = MFMA16(frag_from(lds_ld16(lds + 9216 + rowl * 144 + 64 * s + 16 * q)), frag_from(lds_ld16(lfr + (2 + s) * 1024)), acca); }
#pragma unroll
                for (int s = 0; s < 4; ++s) accg = MFMA16(frag_from(lds_ld16(lds + 18432 + rowl * 272 + 64 * s + 16 * q)), frag_from(lds_ld16(lfr + (4 + s) * 1024)), accg);
                const int c = c8 + 4 * e;
                const f32x4 w0v = *(const LAS f32x4*)(lpar + c), a0v = *(const LAS f32x4*)(lpar + 512 + c), kkv = *(const LAS f32x4*)(lpar + 1024 + c), kav = *(const LAS f32x4*)(lpar + 1536 + c);
                float ldl[4];
#pragma unroll
                for (int j = 0; j < 4; ++j) {
                    const float wl = w0v[j] + accw[j]; const float z = -wl;
                    const float sp = fmaxf(z, 0.f) + __logf(1.0f + __expf(-fabsf(z)));
                    ldl[j] = -__expf(-sp - 0.5f);
                    const float a = sigm(a0v[j] + acca[j]); av[ct][j] = a; gvl[4 * e + j] = accg[j];
                    const float kk = k8[4 * e + j] * kkv[j]; kkr[ct][j] = kk; ss += kk * kk;
                    kxl[4 * e + j] = k8[4 * e + j] * (1.0f + (a - 1.0f) * kav[j]);
                }
                *(u32x2*)(SLD + (size_t)bt * 512 + c) = pack4(ldl[0], ldl[1], ldl[2], ldl[3]);
            }
            const size_t o = (size_t)bt * 512 + c8;
            *(u32x4*)(SR + o) = __builtin_bit_cast(u32x4, pack8(r8)); *(u32x4*)(SV + o) = __builtin_bit_cast(u32x4, pack8(v8));
            *(u32x4*)(SK + o) = __builtin_bit_cast(u32x4, pack8(kxl)); *(u32x4*)(SG + o) = __builtin_bit_cast(u32x4, pack8(gvl));
        }
        ss = qsum(ss);
        const float inv = rsqrtf(fmaxf(ss, 1e-12f));
#pragma unroll
        for (int u = 0; u < 2; ++u) { const size_t o = (size_t)bt * 512 + h * 64 + 32 * u + 8 * q; const int c0 = 2 * u, c1 = 2 * u + 1;
            float ka[4], kb[4], aa[4], ab[4];
#pragma unroll
            for (int j = 0; j < 4; ++j) { ka[j] = kkr[c0][j] * inv; kb[j] = kkr[c1][j] * inv; aa[j] = ka[j] * av[c0][j]; ab[j] = kb[j] * av[c1][j]; }
            ST8(SKK, ka, kb); ST8(SKKA, aa, ab);
        }
#undef ST8
    }
}

__device__ __forceinline__ float gelu_t(float x) { return 0.5f * x * (1.0f + tanh_f(0.7978845608028654f * (x + 0.044715f * x * x * x))); }
__device__ __forceinline__ void compress_wg_task(const Prm& p, LAS unsigned char* lds, int wt, int wave, int lane) {
    const int st = wave >> 2, hq = wave & 3, task = wt * 2 + st;
    const int which = task / 254, tile = task - which * 254, tk = lane & 15, q = lane >> 4;
    const int row = tile * 16 + tk; const int b = row / 254, rem = row - b * 254, n = rem >> 1, g = rem & 1;
    const bf16_t* KV6 = (const bf16_t*)(p.ws + WS_KV6); const float* pe = which ? p.in[16] : p.in[15];
    const bf16_t* W1 = (const bf16_t*)(p.ws + (which ? WS_CV1T : WS_CK1T)) + (size_t)(32 * hq + tk) * 2048 + 8 * q; const bf16_t* W2 = (const bf16_t*)(p.ws + (which ? WS_CV2T : WS_CK2T));
    const bf16_t* src = KV6 + (size_t)(b * SEQ + 16 * n) * 768 + which * 128 + g * 64 + 8 * q;
    f32x4 acc0 = {0.f, 0.f, 0.f, 0.f}, acc1 = {0.f, 0.f, 0.f, 0.f};
#pragma unroll 4
    for (int s = 0; s < 64; ++s) {
        const int l = s >> 1, d = (s & 1) * 32;
        float f[8]; unpack8(ld16(src + (size_t)l * 768 + d), f);
        const f32x4 p0 = *(const f32x4*)(pe + l * 64 + d + 8 * q), p1 = *(const f32x4*)(pe + l * 64 + d + 8 * q + 4);
#pragma unroll
        for (int i = 0; i < 4; ++i) { f[i] += p0[i]; f[4 + i] += p1[i]; }
        const bf16x8 xb = pack8(f);
        acc0 = MFMA16(frag_from(ld16(W1 + 32 * s)), xb, acc0); acc1 = MFMA16(frag_from(ld16(W1 + 16 * 2048 + 32 * s)), xb, acc1);
    }
#pragma unroll
    for (int j = 0; j < 4; ++j) { acc0[j] = gelu_t(acc0[j]); acc1[j] = gelu_t(acc1[j]); }
    const bf16x8 hb = frag_pk(acc0, acc1);
    LAS float* red = (LAS float*)lds + (st * 4 + hq) * 1024 + lane * 16;
#pragma unroll
    for (int ot = 0; ot < 4; ++ot) { const bf16_t* w = W2 + (16 * ot + tk) * 128 + 32 * hq + 4 * q;
        const f32x4 d2 = MFMA16(frag_from2(ld8(w), ld8(w + 16)), hb, ((f32x4){0.f, 0.f, 0.f, 0.f}));
        *(LAS f32x4*)(red + 4 * ot) = d2; }
    __syncthreads();
    { const int ot = hq; LAS float* rb = (LAS float*)lds + (st * 4) * 1024 + lane * 16 + 4 * ot;
      const f32x4 d2 = *(const LAS f32x4*)rb + *(const LAS f32x4*)(rb + 1024) + *(const LAS f32x4*)(rb + 2048) + *(const LAS f32x4*)(rb + 3072);
      bf16_t* kc = (bf16_t*)(p.ws + WS_KCMP); bf16_t* vct = (bf16_t*)(p.ws + WS_VCMPT); const int o = 16 * ot + 4 * q;
      if (which == 0) *(u32x2*)(kc + ((size_t)((b * 2 + g) * 128 + n)) * 64 + o) = pack4(d2[0], d2[1], d2[2], d2[3]);
      else {
#pragma unroll
          for (int j = 0; j < 4; ++j) vct[((size_t)((b * 2 + g) * 64 + o + j)) * 128 + n] = (bf16_t)f2bf(d2[j]); } }
    __syncthreads();
}

__device__ __forceinline__ u32x4 lds_ld16(LAS unsigned char* p);
__device__ __forceinline__ u32x2 lds_ld8(LAS unsigned char* p);
__device__ __forceinline__ void cmp_attn_task(const Prm& p, LAS unsigned char* kb, LAS unsigned char* vb, int task, int lane) {
    const int tile = task & 127, g = (task >> 7) & 1, b = task >> 8, tk = lane & 15, q = lane >> 4;
    const int t = tile * 16 + tk; const size_t bt = (size_t)b * SEQ + t;
    const bf16_t* Q = (const bf16_t*)(p.ws + WS_Q);
    const bf16_t* GN = (const bf16_t*)(p.ws + WS_GN); bf16_t* ON = (bf16_t*)(p.ws + WS_ONSA);
    f32x4 ps[8];
#pragma unroll
    for (int c = 0; c < 8; ++c) ps[c] = (f32x4){0.f, 0.f, 0.f, 0.f};
    const int nvalid = (t >= 31) ? ((t - 31) >> 4) + 1 : 0;
#pragma unroll 1
    for (int hp = 0; hp < 4; ++hp) {
        const int h = g * 4 + hp;
        float f0[8], f1[8]; unpack8(ld16(Q + bt * 512 + h * 64 + 8 * q), f0); unpack8(ld16(Q + bt * 512 + h * 64 + 32 + 8 * q), f1);
#pragma unroll
        for (int i = 0; i < 8; ++i) { f0[i] *= 0.125f; f1[i] *= 0.125f; }
        const bf16x8 qf0 = pack8(f0), qf1 = pack8(f1);
        f32x4 s[8]; float mx = -1e30f;
#pragma unroll
        for (int c = 0; c < 8; ++c) { LAS unsigned char* kr = kb + (16 * c + tk) * 144 + 16 * q;
            s[c] = MFMA16(frag_from(lds_ld16(kr)), qf0, ((f32x4){0.f, 0.f, 0.f, 0.f})); s[c] = MFMA16(frag_from(lds_ld16(kr + 64)), qf1, s[c]);
#pragma unroll
            for (int j = 0; j < 4; ++j) { const int n = 16 * c + 4 * q + j; if (n < nvalid) mx = fmaxf(mx, s[c][j]); }
            if (c & 1) __builtin_amdgcn_sched_barrier(0); }
        mx = qmax(mx);
        float l = 0.f;
#pragma unroll
        for (int c = 0; c < 8; ++c)
#pragma unroll
            for (int j = 0; j < 4; ++j) { const int n = 16 * c + 4 * q + j; const float e = (n < nvalid) ? __expf(s[c][j] - mx) : 0.f; s[c][j] = e; l += e; }
        l = qsum(l);
        const float il = 1.0f / fmaxf(l, 1e-30f);
#pragma unroll
        for (int c = 0; c < 8; ++c) { s[c] = s[c] * il; ps[c] = ps[c] + s[c]; }
        const float gate = bf1(GN[bt * 32 + h * 3 + 0]);
#pragma unroll
        for (int dt = 0; dt < 4; ++dt) { f32x4 o = {0.f, 0.f, 0.f, 0.f};
#pragma unroll
            for (int s2 = 0; s2 < 4; ++s2) { LAS unsigned char* v = vb + (16 * dt + tk) * 272 + 64 * s2 + 8 * q;
                o = MFMA16(frag_from2(lds_ld8(v), lds_ld8(v + 32)), frag_pk(s[2 * s2], s[2 * s2 + 1]), o); }
            *(u32x2*)(ON + bt * 512 + h * 64 + 16 * dt + 4 * q) = pack4(o[0] * gate, o[1] * gate, o[2] * gate, o[3] * gate); }
    }
    const int src = (lane + 48) & 63, cur = t >> 6;
    float imp[8];
#pragma unroll
    for (int c = 0; c < 8; ++c) {
        const float a = __shfl(ps[c][3], src); const float bb = (c > 0) ? __shfl(ps[c > 0 ? c - 1 : 0][3], src) : 0.f;
        const float prev = (q == 0) ? bb : a; const int j = 4 * c + q;
        float v = 0.5f * prev + ps[c][0] + ps[c][1] + ps[c][2] + 0.5f * ps[c][3];
        if (j == 0 || j == cur || j == cur - 1) v = 1e4f; else if (j > cur) v = -1.0f;
        imp[c] = v;
    }
    int rank[8];
#pragma unroll
    for (int c = 0; c < 8; ++c) rank[c] = 0;
#pragma unroll
    for (int c2 = 0; c2 < 8; ++c2)
#pragma unroll
        for (int q2 = 0; q2 < 4; ++q2) { const float o = __shfl(imp[c2], q2 * 16 + tk); const int j2 = 4 * c2 + q2;
#pragma unroll
            for (int c = 0; c < 8; ++c) { const int j = 4 * c + q; rank[c] += (o > imp[c] || (o == imp[c] && j2 < j)) ? 1 : 0; } }
    unsigned mask = 0u;
#pragma unroll
    for (int c = 0; c < 8; ++c) if (rank[c] < 8) mask |= 1u << (4 * c + q);
    mask |= __shfl_xor(mask, 16); mask |= __shfl_xor(mask, 32);
    if (q == 0) ((unsigned*)(p.ws + WS_SELM))[(size_t)(b * 2 + g) * SEQ + t] = mask;
}

__device__ __forceinline__ u32x4 lds_ld16(LAS unsigned char* p) { return *(const LAS u32x4*)p; }
__device__ __forceinline__ u32x2 lds_ld8(LAS unsigned char* p) { return *(const LAS u32x2*)p; }
__device__ __forceinline__ void nsa_wg_task(const Prm& p, LAS unsigned char* lds, int k, int tid, int wave, int lane, int& it) {
    const int r = k >> 8, w = k & 255, qt = (r & 1) ? 31 - (w & 31) : (w & 31), bg = (w >> 5) + 8 * r, b = bg >> 1, g = bg & 1;
    const int hp = wave & 3, h = g * 4 + hp, th = wave >> 2, tk = lane & 15, q = lane >> 4, t0 = qt * 64, cur = qt;
    const bf16_t* Q = (const bf16_t*)(p.ws + WS_Q); const bf16_t* KV6 = (const bf16_t*)(p.ws + WS_KV6) + (size_t)b * SEQ * 768;
    const bf16_t* GN = (const bf16_t*)(p.ws + WS_GN); bf16_t* ON = (bf16_t*)(p.ws + WS_ONSA);
    const unsigned* SM = (const unsigned*)(p.ws + WS_SELM) + (size_t)bg * SEQ;
    int tq[2]; size_t btq[2]; bf16x8 qf[2][2]; unsigned mym[2];
#pragma unroll
    for (int ct = 0; ct < 2; ++ct) {
        tq[ct] = t0 + th * 32 + ct * 16 + tk; btq[ct] = (size_t)b * SEQ + tq[ct];
        const f32x2* rope = (const f32x2*)(p.ws + WS_ROPE) + tq[ct] * 32 + 8 * q;
        float x1[8], x2[8], o1[8], o2[8]; unpack8(ld16(Q + btq[ct] * 512 + h * 64 + 8 * q), x1); unpack8(ld16(Q + btq[ct] * 512 + h * 64 + 32 + 8 * q), x2);
#pragma unroll
        for (int i = 0; i < 8; ++i) { const f32x2 cs = rope[i]; o1[i] = (x1[i] * cs[0] - x2[i] * cs[1]) * 0.18033688f; o2[i] = (x2[i] * cs[0] + x1[i] * cs[1]) * 0.18033688f; }
        qf[ct][0] = pack8(o1); qf[ct][1] = pack8(o2); mym[ct] = SM[tq[ct]];
    }
    unsigned um = SM[t0 + lane];
#pragma unroll
    for (int o = 1; o < 64; o <<= 1) um |= __shfl_xor(um, o);
    um = __builtin_amdgcn_readfirstlane(um);
    f32x4 out[2][4];
#pragma unroll
    for (int ct = 0; ct < 2; ++ct)
#pragma unroll
        for (int dt = 0; dt < 4; ++dt) out[ct][dt] = (f32x4){0.f, 0.f, 0.f, 0.f};
    const int srow = tid >> 3, sch = tid & 7;
#pragma unroll
    for (int br = 0; br < 2; ++br) {
        const bf16_t* Ksrc = KV6 + (br ? 512 : 256) + g * 64 + (size_t)srow * 768 + sch * 8;
        const bf16_t* Vsrc = (const bf16_t*)(p.ws + (br ? WS_VWT : WS_VST)) + (size_t)bg * 64 * SEQ + (size_t)srow * SEQ + sch * 8;
        unsigned todo = br ? (((cur >= 8) ? (0x1ffu << (cur - 8)) : ((2u << cur) - 1u))) : (um & ((cur == 31) ? 0xffffffffu : ((2u << cur) - 1u)));
        float m[2] = {-1e30f, -1e30f}, l[2] = {0.f, 0.f}; f32x4 o[2][4];
#pragma unroll
        for (int ct = 0; ct < 2; ++ct)
#pragma unroll
            for (int dt = 0; dt < 4; ++dt) o[ct][dt] = (f32x4){0.f, 0.f, 0.f, 0.f};
#define NSA_POP(jv) do { jv = todo ? (int)__builtin_ctz(todo) : -1; if (todo) todo &= todo - 1u; } while (0)
#define NSA_LOAD(jv, kr_, vr_) do { if (jv >= 0) { kr_ = ld16(Ksrc + (size_t)(64 * jv) * 768); vr_ = ld16(Vsrc + 64 * jv); } } while (0)
#define NSA_STEP(jv, kr_, vr_) { if (jv < 0) break; \
            LAS unsigned char* kb = lds + (it & 1) * 18432; LAS unsigned char* vb = kb + 9216; ++it; \
            *(LAS u32x4*)(kb + srow * 144 + sch * 16) = kr_; *(LAS u32x4*)(vb + srow * 144 + sch * 16) = vr_; \
            __syncthreads(); \
            const int jc = jv, k0 = 64 * jc; NSA_POP(jv); NSA_LOAD(jv, kr_, vr_); \
            nsa_compute(kb, vb, jc, k0); }
        auto nsa_compute = [&](LAS unsigned char* kb, LAS unsigned char* vb, const int jc, const int k0) __attribute__((always_inline)) {
            f32x4 s[2][4];
#pragma unroll
            for (int c = 0; c < 4; ++c) { const bf16x8 kf0 = frag_from(lds_ld16(kb + (16 * c + tk) * 144 + 16 * q)), kf1 = frag_from(lds_ld16(kb + (16 * c + tk) * 144 + 64 + 16 * q));
#pragma unroll
                for (int ct = 0; ct < 2; ++ct) { s[ct][c] = MFMA16(kf0, qf[ct][0], ((f32x4){0.f, 0.f, 0.f, 0.f})); s[ct][c] = MFMA16(kf1, qf[ct][1], s[ct][c]); } }
            bf16x8 pf[2][2];
            const bool partial = (jc == cur) || (br == 1 && jc == cur - 8);
#pragma unroll
            for (int ct = 0; ct < 2; ++ct) {
                const int t = tq[ct]; const bool sel = br ? true : (((mym[ct] >> jc) & 1u) != 0u); float bm = -1e30f, ls = 0.f, mn, sc;
                if (partial) {
#pragma unroll
                    for (int c = 0; c < 4; ++c)
#pragma unroll
                        for (int jj = 0; jj < 4; ++jj) { const int key = k0 + 16 * c + 4 * q + jj; const bool ok = sel && key <= t && (br == 0 || key > t - 512); if (ok) bm = fmaxf(bm, s[ct][c][jj]); }
                    bm = qmax(bm);
                    mn = fmaxf(m[ct], bm); sc = __builtin_amdgcn_exp2f(m[ct] - mn); m[ct] = mn;
#pragma unroll
                    for (int c = 0; c < 4; ++c)
#pragma unroll
                        for (int jj = 0; jj < 4; ++jj) { const int key = k0 + 16 * c + 4 * q + jj; const bool ok = sel && key <= t && (br == 0 || key > t - 512);
                            const float e = ok ? __builtin_amdgcn_exp2f(s[ct][c][jj] - mn) : 0.f; s[ct][c][jj] = e; ls += e; }
                } else {
#pragma unroll
                    for (int c = 0; c < 4; ++c) bm = fmaxf(bm, fmaxf(fmaxf(s[ct][c][0], s[ct][c][1]), fmaxf(s[ct][c][2], s[ct][c][3])));
                    bm = sel ? bm : -1e30f;
                    bm = qmax(bm);
                    mn = fmaxf(m[ct], bm); sc = __builtin_amdgcn_exp2f(m[ct] - mn); m[ct] = mn;
                    const float mq = sel ? mn : 3e38f;
#pragma unroll
                    for (int c = 0; c < 4; ++c)
#pragma unroll
                        for (int jj = 0; jj < 4; ++jj) { const float e = __builtin_amdgcn_exp2f(s[ct][c][jj] - mq); s[ct][c][jj] = e; ls += e; }
                }
                l[ct] = l[ct] * sc + ls;
#pragma unroll
                for (int dt = 0; dt < 4; ++dt) o[ct][dt] = o[ct][dt] * sc;
                pf[ct][0] = frag_pk(s[ct][0], s[ct][1]); pf[ct][1] = frag_pk(s[ct][2], s[ct][3]);
            }
#pragma unroll
            for (int dt = 0; dt < 4; ++dt) { LAS unsigned char* vr = vb + (16 * dt + tk) * 144 + 8 * q;
                const bf16x8 va0 = frag_from2(lds_ld8(vr), lds_ld8(vr + 32)), va1 = frag_from2(lds_ld8(vr + 64), lds_ld8(vr + 96));
#pragma unroll
                for (int ct = 0; ct < 2; ++ct) { o[ct][dt] = MFMA16(va0, pf[ct][0], o[ct][dt]); o[ct][dt] = MFMA16(va1, pf[ct][1], o[ct][dt]); } }
        };
        int ja, jb, jcx; NSA_POP(ja); NSA_POP(jb); NSA_POP(jcx);
        u32x4 ka = {0u, 0u, 0u, 0u}, va = ka, kbr = ka, vbr = ka, kcr = ka, vcr = ka;
        NSA_LOAD(ja, ka, va); NSA_LOAD(jb, kbr, vbr); NSA_LOAD(jcx, kcr, vcr);
        for (;;) { NSA_STEP(ja, ka, va) NSA_STEP(jb, kbr, vbr) NSA_STEP(jcx, kcr, vcr) }
#undef NSA_POP
#undef NSA_LOAD
#undef NSA_STEP
#pragma unroll
        for (int ct = 0; ct < 2; ++ct) { float lt = l[ct]; lt = qsum(lt);
            const float gs = bf1(GN[btq[ct] * 32 + h * 3 + 1 + br]) / fmaxf(lt, 1e-30f);
#pragma unroll
            for (int dt = 0; dt < 4; ++dt) out[ct][dt] = out[ct][dt] + o[ct][dt] * gs; }
    }
#pragma unroll
    for (int ct = 0; ct < 2; ++ct)
#pragma unroll
        for (int dt = 0; dt < 4; ++dt) { bf16_t* op = ON + btq[ct] * 512 + h * 64 + 16 * dt + 4 * q; float c[4]; unpack4(ld8(op), c);
            *(u32x2*)op = pack4(c[0] + out[ct][dt][0], c[1] + out[ct][dt][1], c[2] + out[ct][dt][2], c[3] + out[ct][dt][3]); }
}

constexpr int SCAN_BUF = 49152;
__device__ __forceinline__ void scan_task(const Prm& p, LAS unsigned char* lds, int task, int tid, int wave, int lane, int& it) {
    const int bh = task >> 1, half = task & 1, b = bh >> 3, h = bh & 7;
    const int jq = lane & 15;
    const size_t base = (size_t)b * SEQ * 512 + h * 64;
    const bf16_t* src[3]; int dst[3]; bool act[3], isld[3], isneg[3];
#pragma unroll
    for (int kx = 0; kx < 3; ++kx) { const int e = tid + 512 * kx; const int ten = e >> 8, within = e & 255, tok = within >> 3, c8 = within & 7;
        act[kx] = e < 1408; isld[kx] = (ten == 1); isneg[kx] = (ten == 3);
        const unsigned char* bp = (ten == 0) ? (const unsigned char*)p.out + DO_SR : (ten == 1) ? (const unsigned char*)p.out + DO_SLD : (ten == 2) ? (const unsigned char*)p.out + DO_SK : (ten == 3) ? p.ws + WS_SKK : (ten == 4) ? p.ws + WS_SKKA : (const unsigned char*)p.out + DO_SV;
        if (ten < 5) { src[kx] = (const bf16_t*)bp + base + (size_t)tok * 512 + c8 * 8; dst[kx] = ten * 8192 + (tok * 64 + c8 * 8) * 4; }
        else { const int w2 = e - 1280, tok2 = w2 >> 2, c2 = w2 & 3; src[kx] = (const bf16_t*)bp + base + (size_t)tok2 * 512 + half * 32 + c2 * 8; dst[kx] = 40960 + (tok2 * 32 + c2 * 8) * 4; }
    }
    const int rg = lane >> 4, irow = half * 32 + (wave & 3) * 8 + rg * 2;
    bf16_t* Yf = (bf16_t*)(p.ws + WS_Y) + base + half * 32;
    f32x2 A01 = {0.f, 0.f}, A23 = {0.f, 0.f}, B01 = {0.f, 0.f}, B23 = {0.f, 0.f};
    const int ht = task * 2 + (wave - 4); const bool hact = (wave == 4 || wave == 5) && ht < 508;
    const int cwhich = ht / 254, ctile = ht - cwhich * 254, ctk = lane & 15, cq = lane >> 4, crow = ctile * 16 + ctk, cb = crow / 254, crem = crow - cb * 254, cn = crem >> 1, cg = crem & 1;
    const float* cpe = cwhich ? p.in[16] : p.in[15];
    const bf16_t* cW1 = (const bf16_t*)(p.ws + (cwhich ? WS_CV1T : WS_CK1T)) + (size_t)ctk * 2048 + 8 * cq;
    const bf16_t* csrc = (const bf16_t*)(p.ws + WS_KV6) + (size_t)(cb * SEQ + 16 * cn) * 768 + cwhich * 128 + cg * 64 + 8 * cq;
    f32x4 cacc[8];
#pragma unroll
    for (int c = 0; c < 8; ++c) cacc[c] = (f32x4){0.f, 0.f, 0.f, 0.f};
    u32x4 reg[3];
#pragma unroll
    for (int kx = 0; kx < 3; ++kx) reg[kx] = act[kx] ? ld16(src[kx]) : (u32x4){0u, 0u, 0u, 0u};
    for (int blk = 0; blk < SEQ / 32; ++blk) {
        LAS unsigned char* buf = lds + (it & 1) * SCAN_BUF; ++it;
#pragma unroll
        for (int kx = 0; kx < 3; ++kx) if (act[kx]) { float f[8]; unpack8(reg[kx], f);
            if (isld[kx]) {
#pragma unroll
                for (int x = 0; x < 8; ++x) f[x] = __expf(f[x]); }
            if (isneg[kx]) {
#pragma unroll
                for (int x = 0; x < 8; ++x) f[x] = -f[x]; }
            *(LAS f32x4*)(buf + dst[kx]) = (f32x4){f[0], f[1], f[2], f[3]}; *(LAS f32x4*)(buf + dst[kx] + 16) = (f32x4){f[4], f[5], f[6], f[7]}; }
        __syncthreads();
        if (blk + 1 < SEQ / 32) {
#pragma unroll
            for (int kx = 0; kx < 3; ++kx) if (act[kx]) reg[kx] = ld16(src[kx] + (size_t)(blk + 1) * 32 * 512); }
        if (tid >= 384 && blk > 0) {
            LAS unsigned char* yb = lds + ((it & 1)) * SCAN_BUF + 45056; const int ft = (tid - 384) >> 2, fc = (tid - 384) & 3;
            const f32x4 y0v = *(const LAS f32x4*)(yb + (ft * 32 + fc * 8) * 4), y1v = *(const LAS f32x4*)(yb + (ft * 32 + fc * 8 + 4) * 4);
            u32x4 o; o.x = pk2(y0v[0], y0v[1]); o.y = pk2(y0v[2], y0v[3]); o.z = pk2(y1v[0], y1v[1]); o.w = pk2(y1v[2], y1v[3]);
            *(u32x4*)(Yf + (size_t)((blk - 1) * 32 + ft) * 512 + fc * 8) = o; }
        if (hact) { const int sx = blk, l = sx >> 1, d = (sx & 1) * 32;
            float f[8]; unpack8(ld16(csrc + (size_t)l * 768 + d), f);
            const f32x4 p0 = *(const f32x4*)(cpe + l * 64 + d + 8 * cq), p1 = *(const f32x4*)(cpe + l * 64 + d + 8 * cq + 4);
#pragma unroll
            for (int i = 0; i < 4; ++i) { f[i] += p0[i]; f[4 + i] += p1[i]; }
            const bf16x8 xb = pack8(f);
#pragma unroll
            for (int c = 0; c < 8; ++c) cacc[c] = MFMA16(frag_from(ld16(cW1 + (size_t)(16 * c) * 2048 + 32 * sx)), xb, cacc[c]); }
        if (wave < 4) {
            LAS unsigned char* lp = buf + jq * 16; LAS unsigned char* vp = buf + 40960 + ((wave & 3) * 8 + rg * 2) * 4;
            f32x4 nr = *(const LAS f32x4*)(lp), nw = *(const LAS f32x4*)(lp + 8192), nk = *(const LAS f32x4*)(lp + 16384), nkk = *(const LAS f32x4*)(lp + 24576), nka = *(const LAS f32x4*)(lp + 32768);
            f32x2 nv = *(const LAS f32x2*)(vp);
#pragma unroll
            for (int tt = 0; tt < 32; ++tt) {
                const f32x4 r = nr, w = nw, kv = nk, kk = nkk, ka = nka; const f32x2 v = nv;
                if (tt < 31) { nr = *(const LAS f32x4*)(lp + (tt + 1) * 256); nw = *(const LAS f32x4*)(lp + 8192 + (tt + 1) * 256); nk = *(const LAS f32x4*)(lp + 16384 + (tt + 1) * 256);
                    nkk = *(const LAS f32x4*)(lp + 24576 + (tt + 1) * 256); nka = *(const LAS f32x4*)(lp + 32768 + (tt + 1) * 256); nv = *(const LAS f32x2*)(vp + (tt + 1) * 128); }
                const f32x2 kk01 = {kk[0], kk[1]}, kk23 = {kk[2], kk[3]}, w01 = {w[0], w[1]}, w23 = {w[2], w[3]}, ka01 = {ka[0], ka[1]}, ka23 = {ka[2], ka[3]}, k01 = {kv[0], kv[1]}, k23 = {kv[2], kv[3]}, r01 = {r[0], r[1]}, r23 = {r[2], r[3]};
                const f32x2 da = A01 * kk01 + A23 * kk23, db = B01 * kk01 + B23 * kk23;
                float sa, sb; red16_pair(da[0] + da[1], db[0] + db[1], (lane & 1) != 0, sa, sb);
                A01 = A01 * w01 + ka01 * sa + k01 * v[0]; A23 = A23 * w23 + ka23 * sa + k23 * v[0];
                B01 = B01 * w01 + ka01 * sb + k01 * v[1]; B23 = B23 * w23 + ka23 * sb + k23 * v[1];
                const f32x2 ya = A01 * r01 + A23 * r23, yb = B01 * r01 + B23 * r23;
                const float yq = red16_pair_nb(ya[0] + ya[1], yb[0] + yb[1], (lane & 1) != 0);
                if (jq < 2) *(LAS float*)(buf + 45056 + (tt * 32 + (wave & 3) * 8 + rg * 2 + jq) * 4) = yq;
            }
        }
    }
    __syncthreads();
    if (tid >= 384) {
        LAS unsigned char* yb = lds + ((it - 1) & 1) * SCAN_BUF + 45056; const int ft = (tid - 384) >> 2, fc = (tid - 384) & 3;
        const f32x4 y0v = *(const LAS f32x4*)(yb + (ft * 32 + fc * 8) * 4), y1v = *(const LAS f32x4*)(yb + (ft * 32 + fc * 8 + 4) * 4);
        u32x4 o; o.x = pk2(y0v[0], y0v[1]); o.y = pk2(y0v[2], y0v[3]); o.z = pk2(y1v[0], y1v[1]); o.w = pk2(y1v[2], y1v[3]);
        *(u32x4*)(Yf + (size_t)((SEQ / 32 - 1) * 32 + ft) * 512 + fc * 8) = o; }
    if (hact) {
        const bf16_t* W2 = (const bf16_t*)(p.ws + (cwhich ? WS_CV2T : WS_CK2T));
#pragma unroll
        for (int c = 0; c < 8; ++c) { cacc[c][0] = gelu_t(cacc[c][0]); cacc[c][1] = gelu_t(cacc[c][1]); cacc[c][2] = gelu_t(cacc[c][2]); cacc[c][3] = gelu_t(cacc[c][3]); }
        bf16_t* kc = (bf16_t*)(p.ws + WS_KCMP); bf16_t* vct = (bf16_t*)(p.ws + WS_VCMPT);
#pragma unroll
        for (int ot = 0; ot < 4; ++ot) {
            f32x4 d2 = {0.f, 0.f, 0.f, 0.f};
#pragma unroll
            for (int s2 = 0; s2 < 4; ++s2) { const bf16_t* w = W2 + (16 * ot + ctk) * 128 + 32 * s2 + 4 * cq;
                d2 = MFMA16(frag_from2(ld8(w), ld8(w + 16)), frag_pk(cacc[2 * s2], cacc[2 * s2 + 1]), d2); }
            const int o = 16 * ot + 4 * cq;
            if (cwhich == 0) *(u32x2*)(kc + ((size_t)((cb * 2 + cg) * 128 + cn)) * 64 + o) = pack4(d2[0], d2[1], d2[2], d2[3]);
            else {
#pragma unroll
                for (int j = 0; j < 4; ++j) vct[((size_t)((cb * 2 + cg) * 64 + o + j)) * 128 + cn] = (bf16_t)f2bf(d2[j]); }
        }
    }
}
__device__ __forceinline__ void rw_post_token(const Prm& p, int bt, int lane) {
    const size_t o = (size_t)bt * 512 + 8 * lane;
    bf16_t* Y = (bf16_t*)(p.ws + WS_Y);
    float y[8], r[8], k[8], v[8], g[8];
    unpack8(ld16(Y + o), y); unpack8(ld16((const bf16_t*)((const unsigned char*)p.out + DO_SR) + o), r); unpack8(ld16((const bf16_t*)((const unsigned char*)p.out + DO_SK) + o), k);
    unpack8(ld16((const bf16_t*)((const unsigned char*)p.out + DO_SV) + o), v); unpack8(ld16((const bf16_t*)(p.ws + WS_G) + o), g);
    const float* rk = p.in[12] + 8 * lane; const float* lg = p.in[13] + 8 * lane; const float* lb = p.in[14] + 8 * lane;
    float s = 0.f, dot = 0.f;
#pragma unroll
    for (int i = 0; i < 8; ++i) { s += y[i]; dot += r[i] * k[i] * rk[i]; }
    s += __shfl_xor(s, 1); s += __shfl_xor(s, 2); s += __shfl_xor(s, 4); dot += __shfl_xor(dot, 1); dot += __shfl_xor(dot, 2); dot += __shfl_xor(dot, 4);
    const float mu = s * (1.0f / 64.0f); float vs = 0.f;
#pragma unroll
    for (int i = 0; i < 8; ++i) { const float d = y[i] - mu; vs += d * d; }
    vs += __shfl_xor(vs, 1); vs += __shfl_xor(vs, 2); vs += __shfl_xor(vs, 4);
    const float rs = rsqrtf(vs * (1.0f / 64.0f) + 64e-5f);
    float out[8];
#pragma unroll
    for (int i = 0; i < 8; ++i) out[i] = ((y[i] - mu) * rs * lg[i] + lb[i] + dot * v[i]) * g[i];
    *(u32x4*)(Y + o) = __builtin_bit_cast(u32x4, pack8(out));
}

constexpr int XA_KB = 33792, XA_BUF = 70656;
__device__ __forceinline__ void xattn_wg_task(const Prm& p, LAS unsigned char* lds, int task, int tid, int wave, int lane, int& it) {
    const int tile = task & 15, h = (task >> 4) & 3, b = task >> 6, tk = lane & 15, q = lane >> 4;
    const size_t bt = (size_t)b * SEQ + tile * 128 + wave * 16 + tk;
    const bf16_t* QX = (const bf16_t*)(p.ws + WS_QX) + bt * 1024 + h * 256 + 8 * q;
    const bf16_t* Kg = (const bf16_t*)(p.ws + WS_KX) + (size_t)b * 256 * 1024 + h * 256;
    const bf16_t* Vg = (const bf16_t*)(p.ws + WS_VXT) + (size_t)(b * 4 + h) * 256 * 256;
    bf16_t* OX = (bf16_t*)(p.ws + WS_OX) + bt * 1024 + h * 256;
    bf16x8 qf[8];
#pragma unroll
    for (int s = 0; s < 8; ++s) qf[s] = frag_from(ld16(QX + 32 * s));
    u32x4 kr[4], vr[4];
#pragma unroll
    for (int i = 0; i < 4; ++i) { const int idx = tid + 512 * i; kr[i] = ld16(Kg + (size_t)(idx >> 5) * 1024 + (idx & 31) * 8); vr[i] = ld16(Vg + (size_t)(idx >> 3) * 256 + (idx & 7) * 8); }
    float m = -1e30f, l = 0.f; f32x4 o[16];
#pragma unroll
    for (int dt = 0; dt < 16; ++dt) o[dt] = (f32x4){0.f, 0.f, 0.f, 0.f};
#pragma unroll 1
    for (int blk = 0; blk < 4; ++blk) {
        LAS unsigned char* kb = lds + (it & 1) * XA_BUF; LAS unsigned char* vb = kb + XA_KB; ++it;
#pragma unroll
        for (int i = 0; i < 4; ++i) { const int idx = tid + 512 * i; *(LAS u32x4*)(kb + (idx >> 5) * 528 + (idx & 31) * 16) = kr[i]; *(LAS u32x4*)(vb + (idx >> 3) * 144 + (idx & 7) * 16) = vr[i]; }
        __syncthreads();
        if (blk < 3) { const int k0 = 64 * (blk + 1);
#pragma unroll
            for (int i = 0; i < 4; ++i) { const int idx = tid + 512 * i; kr[i] = ld16(Kg + (size_t)(k0 + (idx >> 5)) * 1024 + (idx & 31) * 8); vr[i] = ld16(Vg + (size_t)(idx >> 3) * 256 + k0 + (idx & 7) * 8); } }
        f32x4 sc[4]; float bm = -1e30f;
#pragma unroll
        for (int c = 0; c < 4; ++c) { f32x4 a = {0.f, 0.f, 0.f, 0.f}; LAS unsigned char* kp = kb + (16 * c + tk) * 528 + 16 * q;
#pragma unroll
            for (int s = 0; s < 8; ++s) a = MFMA16(frag_from(lds_ld16(kp + 64 * s)), qf[s], a);
            a = a * 0.0625f; sc[c] = a; bm = fmaxf(bm, fmaxf(fmaxf(a[0], a[1]), fmaxf(a[2], a[3]))); }
        bm = qmax(bm);
        const float mn = fmaxf(m, bm), scl = __expf(m - mn); m = mn; float ls = 0.f;
#pragma unroll
        for (int c = 0; c < 4; ++c)
#pragma unroll
            for (int j = 0; j < 4; ++j) { const float e = __expf(sc[c][j] - mn); sc[c][j] = e; ls += e; }
        l = l * scl + ls;
        const bf16x8 pf0 = frag_pk(sc[0], sc[1]), pf1 = frag_pk(sc[2], sc[3]);
#pragma unroll
        for (int dt = 0; dt < 16; ++dt) { LAS unsigned char* vp = vb + (16 * dt + tk) * 144 + 8 * q;
            o[dt] = o[dt] * scl;
            o[dt] = MFMA16(frag_from2(lds_ld8(vp), lds_ld8(vp + 32)), pf0, o[dt]); o[dt] = MFMA16(frag_from2(lds_ld8(vp + 64), lds_ld8(vp + 96)), pf1, o[dt]); }
    }
    l = qsum(l);
    const float il = 1.0f / l;
#pragma unroll
    for (int dt = 0; dt < 16; ++dt) *(u32x2*)(OX + 16 * dt + 4 * q) = pack4(o[dt][0] * il, o[dt][1] * il, o[dt][2] * il, o[dt][3] * il);
}

#define XB_TMO      128
#define XB_XCNT(j)  (256  + 64 * (j))
#define XB_XSUB(j)  (1280 + 64 * (j))
#define XB_XGEN(j)  (2304 + 64 * (j))
#define XB_TOP      3328
#define XB_TOPGEN   3392
#define XCD_BAR_WORDS 3456
#define XB_SPIN_CAP (1u << 18)

__device__ __forceinline__ unsigned xb_ld(unsigned* p)              { return __hip_atomic_load(p, __ATOMIC_RELAXED, __HIP_MEMORY_SCOPE_AGENT); }
__device__ __forceinline__ unsigned xb_add(unsigned* p, unsigned v) { return __hip_atomic_fetch_add(p, v, __ATOMIC_RELAXED, __HIP_MEMORY_SCOPE_AGENT); }
__device__ __forceinline__ unsigned xb_xcc_id() { return (unsigned)__builtin_amdgcn_s_getreg((3 << 11) | 20) & 0xFu; }
#define XB_SPIN(cond, bar) do { unsigned _sp = 0; while (cond) { __builtin_amdgcn_s_sleep(1); \
    if ((++_sp & 255u) == 0u) { if (xb_ld(&(bar)[XB_TMO])) break; if (_sp > XB_SPIN_CAP) { atomicAdd(&(bar)[XB_TMO], 1u); break; } } } } while (0)

struct XcdBarrier {
    unsigned* bar; unsigned x;
    volatile LAS unsigned* st;
};

__device__ __forceinline__ XcdBarrier xcd_barrier_post(unsigned* bar, volatile LAS unsigned* st) {
    XcdBarrier b; b.bar = bar; b.x = xb_xcc_id(); b.st = st;
    if (threadIdx.x == 0) (void)xb_add(&bar[XB_XCNT(b.x)], 1u);
    return b;
}
__device__ __forceinline__ void xcd_barrier_complete(unsigned* bar, unsigned x, unsigned& nloc, unsigned& nx) {
    const unsigned G = gridDim.x * gridDim.y * gridDim.z;
    unsigned sum, cnt, mine, sp = 0u;
    for (;;) {
        sum = 0u; cnt = 0u; mine = 0u;
#pragma unroll
        for (unsigned j = 0; j < 16; ++j) { const unsigned c = xb_ld(&bar[XB_XCNT(j)]); sum += c; cnt += (c > 0u) ? 1u : 0u; mine = (j == x) ? c : mine; }
        if (sum == G) break;
        __builtin_amdgcn_s_sleep(1);
        if ((++sp & 255u) == 0u) { if (xb_ld(&bar[XB_TMO])) break; if (sp > XB_SPIN_CAP) { atomicAdd(&bar[XB_TMO], 1u); break; } }
    }
    nloc = mine > 0u ? mine : 1u; nx = cnt > 0u ? cnt : 1u;
}

__device__ __forceinline__ void xcd_barrier(const XcdBarrier& b) {
    asm volatile("s_waitcnt vmcnt(0)" ::: "memory");
    __syncthreads();
    if (threadIdx.x == 0) {
        unsigned* bar = b.bar;
        __builtin_amdgcn_s_waitcnt(0);
        unsigned nloc = b.st[0], nx = b.st[1];
        if (nloc == 0u) { xcd_barrier_complete(bar, b.x, nloc, nx); b.st[0] = nloc; b.st[1] = nx; }
        const unsigned old = xb_add(&bar[XB_XSUB(b.x)], 1u);
        const unsigned gen = old / nloc;
        if (old + 1u == (gen + 1u) * nloc) {
            __builtin_amdgcn_fence(__ATOMIC_RELEASE, "agent");
            asm volatile("s_waitcnt vmcnt(0)" ::: "memory");
            const unsigned og = xb_add(&bar[XB_TOP], 1u);
            const unsigned tg = og / nx;
            if (og + 1u == (tg + 1u) * nx) xb_add(&bar[XB_TOPGEN], 1u);
            else XB_SPIN(xb_ld(&bar[XB_TOPGEN]) == tg, bar);
            __builtin_amdgcn_fence(__ATOMIC_ACQUIRE, "agent");
            xb_add(&bar[XB_XGEN(b.x)], 1u);
            asm volatile("s_waitcnt vmcnt(0)" ::: "memory");
        } else {
            XB_SPIN(xb_ld(&bar[XB_XGEN(b.x)]) == gen, bar);
            __builtin_amdgcn_fence(__ATOMIC_ACQUIRE, "agent");
            asm volatile("s_waitcnt vmcnt(0)" ::: "memory");
        }
    }
    __syncthreads();
}

__global__ void __launch_bounds__(512, 2) hybrid_fwd(Prm p, int ph_lo, int ph_hi) {
    extern __shared__ __attribute__((aligned(16))) unsigned char lds_raw[];
    LAS unsigned char* lds = (LAS unsigned char*)lds_raw;
    cg::grid_group grid = cg::this_grid();
    const int tid = threadIdx.x, lane = tid & 63, wave = __builtin_amdgcn_readfirstlane(tid >> 6);
    const int G = gridDim.x, gw = blockIdx.x * 8 + wave, NGW = G * 8, gt = blockIdx.x * 512 + tid, NGT = G * 512;
    unsigned char* ws = p.ws;
    volatile LAS unsigned* bst = (volatile LAS unsigned*)(lds + LDS_BYTES - 64);
    if (tid < 16) bst[tid] = 0u;
    __syncthreads();
    XcdBarrier xbar = xcd_barrier_post((unsigned*)ws, bst);
    if (ph_lo < 0) grid.sync();
#define GSYNC() xcd_barrier(xbar)
#ifndef DUP_MASK
#define DUP_MASK 0
#endif
#define PHASE(k, ...) if (ph_lo <= (k) && (k) < ph_hi) { _Pragma("unroll 1") for (int rep = 0; rep <= ((DUP_MASK >> (k)) & 1); ++rep) { __VA_ARGS__ if (rep < ((DUP_MASK >> (k)) & 1)) GSYNC(); } } if (ph_lo <= (k) && (k) + 1 < ph_hi) GSYNC();
    PHASE(0, {
        LAS float* scr = (LAS float*)(lds + wave * 8448); int off = gw;
        transpose_w(p.in[3], 1024, 5144, (bf16_t*)(ws + WS_WIN), 1, scr, lane, off, NGW);
        transpose_w(p.in[30], 1024, 5632, (bf16_t*)(ws + WS_WGU), 2, scr, lane, off, NGW, p.in[29]);
        transpose_w(p.in[31], 2816, 1024, (bf16_t*)(ws + WS_WDOWN), 0, scr, lane, off, NGW);
        transpose_w(p.in[27], 1024, 2048, (bf16_t*)(ws + WS_WKV), 0, scr, lane, off, NGW);
        transpose_w(p.in[23], 1024, 1024, (bf16_t*)(ws + WS_WOUT), 0, scr, lane, off, NGW);
        transpose_w(p.in[26], 1024, 1024, (bf16_t*)(ws + WS_WQ), 0, scr, lane, off, NGW, p.in[24]);
        transpose_w(p.in[28], 1024, 1024, (bf16_t*)(ws + WS_WO), 0, scr, lane, off, NGW);
        transpose_w(p.in[21], 512, 1024, (bf16_t*)(ws + WS_WUPRW), 0, scr, lane, off, NGW);
        transpose_w(p.in[22], 512, 1024, (bf16_t*)(ws + WS_WUPNSA), 0, scr, lane, off, NGW);
        transpose_w(p.in[5], 64, 512, (bf16_t*)(ws + WS_LORA_W), 0, scr, lane, off, NGW);
        transpose_w(p.in[7], 64, 512, (bf16_t*)(ws + WS_LORA_A), 0, scr, lane, off, NGW);
        transpose_w(p.in[9], 128, 512, (bf16_t*)(ws + WS_LORA_G), 0, scr, lane, off, NGW);
        transpose_w(p.in[17], 2048, 128, (bf16_t*)(ws + WS_CK1T), 0, scr, lane, off, NGW);
        transpose_w(p.in[19], 2048, 128, (bf16_t*)(ws + WS_CV1T), 0, scr, lane, off, NGW);
        transpose_w(p.in[18], 128, 64, (bf16_t*)(ws + WS_CK2T), 0, scr, lane, off, NGW);
        transpose_w(p.in[20], 128, 64, (bf16_t*)(ws + WS_CV2T), 0, scr, lane, off, NGW);
        for (int e = gt; e < (NIN - 5144) * 1024 / 2; e += NGT) ((unsigned*)(ws + WS_WIN + (size_t)5144 * 1024 * 2))[e] = 0u;
        for (int e = gt; e < SEQ * 32; e += NGT) { const int d = e & 31, t = e >> 5; const float inv = powf(10000.0f, -(float)d / 32.0f); const float ang = (float)t * inv;
            const double rev = (double)ang * 0.15915494309189535; const float fr = (float)(rev - rint(rev));
            ((f32x2*)(ws + WS_ROPE))[e] = (f32x2){__builtin_amdgcn_cosf(fr), __builtin_amdgcn_sinf(fr)}; }
        for (int e = gt; e < 32 * 64; e += NGT) { const int bg = e >> 6, d = e & 63; ((bf16_t*)(ws + WS_KCMP))[(size_t)(bg * 128 + 127) * 64 + d] = 0; ((bf16_t*)(ws + WS_VCMPT))[(size_t)(bg * 64 + d) * 128 + 127] = 0; }
        norm_rows(p.in[0], p.in[2], (bf16_t*)(ws + WS_XN), MTOK, lane, gw, NGW);
        norm_rows(p.in[1], p.in[25], (bf16_t*)(ws + WS_MEMN), BATCH * NMEM, lane, gw, NGW);
    })
    PHASE(1, {
        EpiInProj E{(bf16_t*)(ws + WS_PRW), (bf16_t*)(ws + WS_Q), (bf16_t*)(ws + WS_KV6), (bf16_t*)(ws + WS_GM), (bf16_t*)(ws + WS_GN)};
        run_gemm(lds, (const bf16_t*)(ws + WS_XN), (const bf16_t*)(ws + WS_WIN), MTOK, NIN, 1024, E);
        EpiMemK E2{(bf16_t*)(ws + WS_KX)};
        run_gemm(lds, (const bf16_t*)(ws + WS_MEMN), (const bf16_t*)(ws + WS_WKV), BATCH * NMEM, 1024, 1024, E2, 128);
        EpiMemVT E3{(bf16_t*)(ws + WS_VXT)};
        run_gemm(lds, (const bf16_t*)(ws + WS_WKV) + (size_t)1024 * 1024, (const bf16_t*)(ws + WS_MEMN), 1024, BATCH * NMEM, 1024, E3, 64);
    })
    PHASE(2, {
        for (int t8 = blockIdx.x; t8 < MTOK / 128; t8 += G) rw_prep_task(p, lds, t8 * 8 + wave, tid, wave, lane);
        bf16_t* KV6 = (bf16_t*)(ws + WS_KV6); const f32x2* rope = (const f32x2*)(ws + WS_ROPE);
        if (rep == 0) for (int e = gt; e < MTOK * 128; e += NGT) { const int d = e & 31, g = (e >> 5) & 1, wh = (e >> 6) & 1, bt = e >> 7;
            bf16_t* x = KV6 + (size_t)bt * 768 + (wh ? 512 : 256) + g * 64 + d; const float x1 = bf1(x[0]), x2 = bf1(x[32]); const f32x2 cs = rope[(bt & (SEQ - 1)) * 32 + d];
            x[0] = (bf16_t)f2bf(x1 * cs[0] - x2 * cs[1]); x[32] = (bf16_t)f2bf(x2 * cs[0] + x1 * cs[1]); }
        for (int e = gt; e < (1 << 20); e += NGT) { const int d = e & 63, tc = (e >> 6) & 255, g = (e >> 14) & 1, b = (e >> 15) & 15, wh = e >> 19;
            const bf16_t* s = KV6 + (size_t)(b * SEQ + 8 * tc) * 768 + (wh ? 640 : 384) + g * 64 + d;
            u32x4 o; o.x = (unsigned)s[0] | ((unsigned)s[768] << 16); o.y = (unsigned)s[2 * 768] | ((unsigned)s[3 * 768] << 16); o.z = (unsigned)s[4 * 768] | ((unsigned)s[5 * 768] << 16); o.w = (unsigned)s[6 * 768] | ((unsigned)s[7 * 768] << 16);
            *(u32x4*)((bf16_t*)(ws + (wh ? WS_VWT : WS_VST)) + ((size_t)((b * 2 + g) * 64 + d)) * SEQ + 8 * tc) = o; }
    })
    PHASE(3, { int itc = 0; for (int task = blockIdx.x; task < 256; task += G) scan_task(p, lds, task, tid, wave, lane, itc); })
    PHASE(4, { for (int wt = blockIdx.x; wt < 512; wt += G) {
            const int bg = wt >> 4; LAS unsigned char* kb = lds; LAS unsigned char* vb = lds + 18432;
            const bf16_t* kc = (const bf16_t*)(ws + WS_KCMP) + (size_t)bg * 128 * 64; const bf16_t* vct = (const bf16_t*)(ws + WS_VCMPT) + (size_t)bg * 64 * 128;
            __syncthreads();
            _Pragma("unroll") for (int i = 0; i < 2; ++i) { const int idx = tid + 512 * i; *(LAS u32x4*)(kb + (idx >> 3) * 144 + (idx & 7) * 16) = ld16(kc + (idx >> 3) * 64 + (idx & 7) * 8); *(LAS u32x4*)(vb + (idx >> 4) * 272 + (idx & 15) * 16) = ld16(vct + (idx >> 4) * 128 + (idx & 15) * 8); }
            __syncthreads();
            cmp_attn_task(p, kb, vb, (bg << 7) + ((wt & 15) << 3) + wave, lane); }
        GSYNC();
        { int itc = 0; for (int k = blockIdx.x; k < 1024; k += G) nsa_wg_task(p, lds, k, tid, wave, lane, itc); }
          for (int bt = gw; bt < MTOK; bt += NGW) rw_post_token(p, bt, lane); })
    PHASE(7, { { EpiGate1 E{(const bf16_t*)(ws + WS_GM), (bf16_t*)(ws + WS_T1)};
        run_gemm(lds, (const bf16_t*)(ws + WS_Y), (const bf16_t*)(ws + WS_WUPRW), MTOK, 1024, 512, E); }
        { EpiGate2 E{(const bf16_t*)(ws + WS_GM), (bf16_t*)(ws + WS_T1)};
        run_gemm(lds, (const bf16_t*)(ws + WS_ONSA), (const bf16_t*)(ws + WS_WUPNSA), MTOK, 1024, 512, E); } })
    PHASE(9, { EpiResidH E{p.in[0], nullptr, (bf16_t*)(ws + WS_XN2), (float*)(ws + WS_SSQ)}; run_gemm(lds, (const bf16_t*)(ws + WS_T1), (const bf16_t*)(ws + WS_WOUT), MTOK, 1024, 1024, E); })
    PHASE(11, { EpiBf16S E{(bf16_t*)(ws + WS_QX), 1024, (const float*)(ws + WS_SSQ)}; run_gemm(lds, (const bf16_t*)(ws + WS_XN2), (const bf16_t*)(ws + WS_WQ), MTOK, 1024, 1024, E); })
    PHASE(12, { int itc = 0; for (int task = blockIdx.x; task < 1024; task += G) xattn_wg_task(p, lds, task, tid, wave, lane, itc); })
    PHASE(13, { EpiResidH E{nullptr, (const bf16_t*)(ws + WS_XN2), (bf16_t*)(ws + WS_XN2), (float*)(ws + WS_SSQ)}; run_gemm(lds, (const bf16_t*)(ws + WS_OX), (const bf16_t*)(ws + WS_WO), MTOK, 1024, 1024, E); })
    PHASE(15, { EpiSwiglu E{(bf16_t*)(ws + WS_HFF), (const float*)(ws + WS_SSQ)}; run_gemm(lds, (const bf16_t*)(ws + WS_XN2), (const bf16_t*)(ws + WS_WGU), MTOK, 2 * DFF, 1024, E); })
    PHASE(16, { EpiResidH E{nullptr, (const bf16_t*)(ws + WS_XN2), (bf16_t*)(ws + WS_OX), (float*)(ws + WS_SSQ)}; run_gemm(lds, (const bf16_t*)(ws + WS_HFF), (const bf16_t*)(ws + WS_WDOWN), MTOK, 1024, DFF, E); })
    PHASE(17, {
        const float* gain = p.in[32]; const bf16_t* hb = (const bf16_t*)(ws + WS_OX); const float* ssq = (const float*)(ws + WS_SSQ);
        f32x4 gv[4];
        _Pragma("unroll") for (int j = 0; j < 4; ++j) gv[j] = ((const f32x4*)gain)[lane + 64 * j];
        for (int m = gw; m < MTOK; m += NGW) {
            u32x2 hv[4];
            _Pragma("unroll") for (int j = 0; j < 4; ++j) hv[j] = ld8(hb + (size_t)m * DM + 4 * (lane + 64 * j));
            const float rs = row_rs(ssq, m);
            f32x4* xo = (f32x4*)(p.out + (size_t)m * DM) + lane;
            _Pragma("unroll") for (int j = 0; j < 4; ++j) { float a[4]; unpack4(hv[j], a); xo[64 * j] = (f32x4){a[0], a[1], a[2], a[3]} * rs * gv[j]; }
        }
    })
#undef PHASE
}

constexpr int NPHASE = 18;
#ifndef MK_MULTI
#define MK_MULTI 0
#endif
extern "C" void kernel_launch(void* const* d_in, const int* in_sizes, int n_in, void* d_out, int out_size, void* d_ws, size_t ws_size, hipStream_t stream) {
    static int grid = 0;
    if (grid == 0) {
        if (n_in != 33 || out_size != MTOK * DM || ws_size < WS_NEED) { fprintf(stderr, "kernel_launch: unexpected shapes (n_in %d out %d ws %zu)\n", n_in, out_size, ws_size); grid = -1; return; }
        int dev = 0, cus = 0, per_cu = 0;
        (void)hipGetDevice(&dev); (void)hipDeviceGetAttribute(&cus, hipDeviceAttributeMultiprocessorCount, dev);
        (void)hipFuncSetAttribute((const void*)hybrid_fwd, hipFuncAttributeMaxDynamicSharedMemorySize, LDS_BYTES);
        (void)hipOccupancyMaxActiveBlocksPerMultiprocessor(&per_cu, (const void*)hybrid_fwd, 512, LDS_BYTES);
        if (per_cu < 1) { fprintf(stderr, "kernel_launch: occupancy query says %d blocks/CU\n", per_cu); per_cu = 1; }
        grid = cus * 1;
        (void)hipGetLastError();
    }
    if (grid < 0) return;
    if (hipMemsetAsync(d_ws, 0, 16384, stream) != hipSuccess) { fprintf(stderr, "kernel_launch: memset of barrier words failed\n"); return; }
    Prm p{};
    for (int i = 0; i < 33; ++i) p.in[i] = (const float*)d_in[i];
    p.out = (float*)d_out; p.ws = (unsigned char*)d_ws;
#if MK_MULTI
    for (int k = 0; k < NPHASE; ++k) { int lo = k, hi = k + 1; hipLaunchKernelGGL(hybrid_fwd, dim3(grid), dim3(512), LDS_BYTES, stream, p, lo, hi); }
#else
    int lo = 0, hi = NPHASE; void* args[] = {&p, &lo, &hi};
    hipError_t e = hipLaunchCooperativeKernel((const void*)hybrid_fwd, dim3(grid), dim3(512), args, LDS_BYTES, stream);
    if (e != hipSuccess) fprintf(stderr, "cooperative launch failed: %s (grid %d)\n", hipGetErrorString(e), grid);
#endif
}
```

```cpp
#include <hip/hip_runtime.h>
#include <hip/hip_cooperative_groups.h>
#include <cstdio>
#include <cstdint>
namespace cg = cooperative_groups;
namespace pg8 {
#define PG8_LAS __attribute__((address_space(3)))
typedef unsigned short bf16_t;
typedef short bf16x8 __attribute__((ext_vector_type(8)));
typedef float f32x4 __attribute__((ext_vector_type(4)));
typedef unsigned u32x4 __attribute__((ext_vector_type(4)));
constexpr int BM = 256, BK = 64, HALF = 128, HTB = HALF * BK * 2  , STAGE_BYTES = 8 * HTB, NXCD = 8, WGM = 8;

__host__ __device__ __forceinline__ int lds_byte(int r, int c) { const int st = (r >> 4) * 2 + (c >> 5), rr = r & 15, cc = c & 31, ob = rr * 64 + cc * 2; return st * 1024 + (ob ^ (((ob >> 9) & 1) << 5)); }
__host__ __device__ __forceinline__ void stage_rc(int b, int& R, int& C) { const int st = b / 1024, sb = b % 1024, swz = sb ^ (((sb >> 9) & 1) << 5); R = (st >> 1) * 16 + swz / 64; C = (st & 1) * 32 + (swz % 64) / 2; }
__host__ __device__ __forceinline__ int perm32(int rho) { const int n = rho >> 4, i = rho & 15; return 8 * (i >> 2) + 4 * n + (i & 3); }

struct Unit { int pm, pn; };
struct Gemm { const bf16_t* A; const bf16_t* Bt; int M, N, K; };

struct StaticOrder {
    int nM, nN, nwg, G, c;
    __host__ __device__ void init(int M, int N, int G_, int c_) { nM = M / BM; nN = N / BM; nwg = nM * nN; G = G_; c = c_; }
    __host__ __device__ bool next(int i, Unit& u) const {
        const long L = (long)i * G + c; if (L >= nwg) return false;
        int wgid = (int)L; { const int q = nwg / NXCD, r = nwg % NXCD, xcd = wgid % NXCD, off = wgid / NXCD; wgid = (xcd < r ? xcd * (q + 1) : r * (q + 1) + (xcd - r) * q) + off; }
        const int nig = WGM * nN, gid = wgid / nig, fm = gid * WGM, gsz = (nM - fm) < WGM ? (nM - fm) : WGM;
        u.pm = fm + ((wgid % nig) % gsz); u.pn = (wgid % nig) / gsz; return true;
    }
    __device__ __forceinline__ void a_ready(const Unit&) const {}
    __device__ __forceinline__ void done(const Unit&) const {}
};
template <class Epi, class Sched, bool ALIGN_EPI = false, bool SP2 = false>
__device__ __forceinline__ void gemm_phase(PG8_LAS unsigned char* lds, const Gemm g, const Sched& S, const Epi& E) {
    const int tid = threadIdx.x, wid = __builtin_amdgcn_readfirstlane(tid >> 6), lane = tid & 63, wr = wid >> 2, wc = wid & 3, fr = lane & 15, fq = lane >> 4;
    const int K = g.K, nt = K / BK;
    unsigned voffA[2], voffB[2];
#pragma unroll
    for (int i = 0; i < 2; ++i) { int R, C; stage_rc(tid * 16 + i * 8192, R, C); const int Rb = Epi::PERM ? ((R & ~31) + perm32(R & 31)) : R;
        voffA[i] = (unsigned)(R * K + C) * 2u; voffB[i] = (unsigned)(Rb * K + C) * 2u; }
    const size_t kstep = (size_t)(BK * 2);
    const size_t hstep = (size_t)HALF * K * 2;
    const size_t tstep = 2 * hstep;
    const unsigned ldsw = (unsigned)wid * 1024u;
    const int aoff = lds_byte(wr * 64 + fr, fq * 8), boff = lds_byte(wc * 32 + fr, fq * 8);
#define PG8_SA(b, h) (((b) * 2 + (h)) * HTB)
#define PG8_SB(b, h) ((4 + (b) * 2 + (h)) * HTB)
#define PG8_STAGE(bufoff, gbase, voff) do { _Pragma("unroll") for (int _i = 0; _i < 2; ++_i) \
        __builtin_amdgcn_global_load_lds((const unsigned*)((const char*)(gbase) + (voff)[_i]), (PG8_LAS unsigned*)(lds + (bufoff) + ldsw + _i * 8192), 16, 0, 0); } while (0)
#define PG8_LDA(dst, b, h) do { _Pragma("unroll") for (int m = 0; m < 4; ++m) _Pragma("unroll") for (int k = 0; k < 2; ++k) dst[m][k] = *(const PG8_LAS bf16x8*)(lds + PG8_SA(b, h) + aoff + m * 2048 + k * 1024); } while (0)
#define PG8_LDB(dst, b, h) do { _Pragma("unroll") for (int n = 0; n < 2; ++n) _Pragma("unroll") for (int k = 0; k < 2; ++k) dst[n][k] = *(const PG8_LAS bf16x8*)(lds + PG8_SB(b, h) + boff + n * 2048 + k * 1024); } while (0)
#define PG8_MMA(ai, bj, At, Bt) do { __builtin_amdgcn_s_setprio(1); _Pragma("unroll") for (int m = 0; m < 4; ++m) _Pragma("unroll") for (int n = 0; n < 2; ++n) _Pragma("unroll") for (int k = 0; k < 2; ++k) \
        acc[ai][bj][m][n] = __builtin_amdgcn_mfma_f32_16x16x32_bf16(Bt[n][k], At[m][k], acc[ai][bj][m][n], 0, 0, 0); __builtin_amdgcn_s_setprio(0); } while (0)
#define PG8_WAIT_V(n) asm volatile("s_waitcnt vmcnt(" #n ")" ::: "memory")
#define PG8_WAIT_L(n) asm volatile("s_waitcnt lgkmcnt(" #n ")" ::: "memory")
#define PG8_BAR __builtin_amdgcn_s_barrier()
#define PG8_SCHED __builtin_amdgcn_sched_barrier(0)
    Unit cur, nxt; int ui = 0;
    if (!S.next(0, cur)) return;
    f32x4 acc[2][2][4][2];
#pragma unroll
    for (int a = 0; a < 2; ++a)
#pragma unroll
        for (int b = 0; b < 2; ++b)
#pragma unroll
            for (int m = 0; m < 4; ++m)
#pragma unroll
                for (int n = 0; n < 2; ++n) acc[a][b][m][n] = (f32x4){0.f, 0.f, 0.f, 0.f};
    bf16x8 At[4][2], B0[2][2], B1[2][2];
    const char* cA = (const char*)g.A + (size_t)cur.pm * tstep; const char* cB = (const char*)g.Bt + (size_t)cur.pn * tstep;
    S.a_ready(cur);
    if constexpr (SP2) {
        PG8_STAGE(PG8_SB(0, 0), cB, voffB); PG8_STAGE(PG8_SB(0, 1), cB + hstep, voffB); PG8_STAGE(PG8_SA(0, 0), cA, voffA); PG8_STAGE(PG8_SA(0, 1), cA + hstep, voffA);
        if (wr == 1) PG8_BAR;
        PG8_WAIT_V(2); PG8_BAR;
        PG8_STAGE(PG8_SB(1, 0), cB + kstep, voffB); PG8_STAGE(PG8_SA(1, 0), cA + kstep, voffA); PG8_STAGE(PG8_SB(1, 1), cB + hstep + kstep, voffB);
        PG8_WAIT_V(6); PG8_BAR;
    } else {
        PG8_STAGE(PG8_SB(0, 0), cB, voffB); PG8_STAGE(PG8_SA(0, 0), cA, voffA); PG8_STAGE(PG8_SB(0, 1), cB + hstep, voffB); PG8_STAGE(PG8_SA(0, 1), cA + hstep, voffA);
        if (wr == 1) PG8_BAR;
        PG8_WAIT_V(4); PG8_BAR;
        PG8_STAGE(PG8_SB(1, 0), cB + kstep, voffB); PG8_STAGE(PG8_SA(1, 0), cA + kstep, voffA); PG8_STAGE(PG8_SB(1, 1), cB + hstep + kstep, voffB);
        PG8_WAIT_V(6); PG8_BAR;
    }
    for (;;) {
        const bool has_next = S.next(ui + 1, nxt);
        const char* nA = has_next ? (const char*)g.A + (size_t)nxt.pm * tstep : cA; const char* nB = has_next ? (const char*)g.Bt + (size_t)nxt.pn * tstep : cB;
        for (int t = 0; t < nt; t += 2) {
            const bool last = (t == nt - 2);
            const char* a1 = cA + (size_t)(t + 1) * kstep;
            const char* a2 = last ? nA : cA + (size_t)(t + 2) * kstep; const char* b2 = last ? nB : cB + (size_t)(t + 2) * kstep;
            const char* a3 = a2 + kstep; const char* b3 = b2 + kstep;
            if (last && has_next) S.a_ready(nxt);
            if constexpr (SP2) {
            PG8_LDB(B0, 0, 0); PG8_LDB(B1, 0, 1); PG8_SCHED; PG8_LDA(At, 0, 0); PG8_STAGE(PG8_SA(1, 1), a1 + hstep, voffA);
            PG8_WAIT_V(8); PG8_WAIT_L(0); PG8_BAR; PG8_MMA(0, 0, At, B0); PG8_MMA(0, 1, At, B1); PG8_BAR; PG8_SCHED;
            PG8_LDA(At, 0, 1); PG8_STAGE(PG8_SB(0, 0), b2, voffB); PG8_STAGE(PG8_SB(0, 1), b2 + hstep, voffB); PG8_STAGE(PG8_SA(0, 0), a2, voffA);
            PG8_WAIT_V(8); PG8_WAIT_L(0); PG8_BAR; PG8_MMA(1, 0, At, B0); PG8_MMA(1, 1, At, B1); PG8_BAR; PG8_SCHED;
            PG8_LDB(B0, 1, 0); PG8_LDB(B1, 1, 1); PG8_SCHED; PG8_LDA(At, 1, 0); PG8_STAGE(PG8_SA(0, 1), a2 + hstep, voffA);
            PG8_WAIT_V(8); PG8_WAIT_L(0); PG8_BAR; PG8_MMA(0, 0, At, B0); PG8_MMA(0, 1, At, B1); PG8_BAR; PG8_SCHED;
            PG8_LDA(At, 1, 1); PG8_STAGE(PG8_SB(1, 0), b3, voffB); PG8_STAGE(PG8_SB(1, 1), b3 + hstep, voffB); PG8_STAGE(PG8_SA(1, 0), a3, voffA);
            PG8_WAIT_V(8); PG8_WAIT_L(0); PG8_BAR; PG8_MMA(1, 0, At, B0); PG8_MMA(1, 1, At, B1); PG8_BAR; PG8_SCHED;
            } else {
            PG8_LDB(B0, 0, 0); PG8_SCHED; PG8_LDA(At, 0, 0); PG8_STAGE(PG8_SA(1, 1), a1 + hstep, voffA);
            PG8_WAIT_L(8); PG8_BAR; PG8_WAIT_L(0); PG8_MMA(0, 0, At, B0); PG8_BAR; PG8_SCHED;
            PG8_LDB(B1, 0, 1); PG8_STAGE(PG8_SB(0, 0), b2, voffB);
            PG8_BAR; PG8_WAIT_L(0); PG8_MMA(0, 1, At, B1); PG8_BAR;
            PG8_LDA(At, 0, 1); PG8_STAGE(PG8_SA(0, 0), a2, voffA);
            PG8_BAR; PG8_WAIT_L(0); PG8_MMA(1, 0, At, B0); PG8_BAR; PG8_SCHED;
            PG8_STAGE(PG8_SB(0, 1), b2 + hstep, voffB);
            PG8_WAIT_V(6); PG8_BAR; PG8_MMA(1, 1, At, B1); PG8_BAR;
            PG8_LDB(B0, 1, 0); PG8_SCHED; PG8_LDA(At, 1, 0); PG8_STAGE(PG8_SA(0, 1), a2 + hstep, voffA);
            PG8_WAIT_L(8); PG8_BAR; PG8_WAIT_L(0); PG8_MMA(0, 0, At, B0); PG8_BAR; PG8_SCHED;
            PG8_LDB(B1, 1, 1); PG8_STAGE(PG8_SB(1, 0), b3, voffB);
            PG8_BAR; PG8_WAIT_L(0); PG8_MMA(0, 1, At, B1); PG8_BAR;
            PG8_LDA(At, 1, 1); PG8_STAGE(PG8_SA(1, 0), a3, voffA);
            PG8_BAR; PG8_WAIT_L(0); PG8_MMA(1, 0, At, B0); PG8_BAR; PG8_SCHED;
            PG8_STAGE(PG8_SB(1, 1), b3 + hstep, voffB);
            PG8_WAIT_V(6); PG8_BAR; PG8_MMA(1, 1, At, B1); PG8_BAR;
            }
        }
        if constexpr (ALIGN_EPI) { if (wr == 0) PG8_BAR; }
        if constexpr (!Epi::AFTER_DRAIN) { E(acc, cur, wr, wc, fr, fq); S.done(cur); }
        if (!has_next) break;
#pragma unroll
        for (int a = 0; a < 2; ++a)
#pragma unroll
            for (int b = 0; b < 2; ++b)
#pragma unroll
                for (int m = 0; m < 4; ++m)
#pragma unroll
                    for (int n = 0; n < 2; ++n) acc[a][b][m][n] = (f32x4){0.f, 0.f, 0.f, 0.f};
        cur = nxt; cA = nA; cB = nB; ++ui;
        if constexpr (ALIGN_EPI) { if (wr == 1) PG8_BAR; }
    }
    PG8_WAIT_V(0);
    if constexpr (!ALIGN_EPI) { if (wr == 0) PG8_BAR; }
    PG8_BAR;
    if constexpr (Epi::AFTER_DRAIN) { E.fused(acc, cur, wr, wc, fr, fq, lds, wid, lane); S.done(cur); }
#undef PG8_SA
#undef PG8_SB
#undef PG8_STAGE
#undef PG8_LDA
#undef PG8_LDB
#undef PG8_MMA
#undef PG8_WAIT_V
#undef PG8_WAIT_L
#undef PG8_BAR
#undef PG8_SCHED
}
}

#define LAS __attribute__((address_space(3)))
typedef unsigned short bf16_t;
typedef short bf16x8 __attribute__((ext_vector_type(8)));
typedef float f32x4 __attribute__((ext_vector_type(4)));
typedef float f32x2 __attribute__((ext_vector_type(2)));
typedef unsigned u32x4 __attribute__((ext_vector_type(4)));
typedef unsigned u32x2 __attribute__((ext_vector_type(2)));

constexpr int BATCH = 16, SEQ = 2048, DM = 1024, MTOK = BATCH * SEQ, NMEM = 256, DFF = 2816;
constexpr int NIN = 5376;
constexpr size_t MiB = 1u << 20;
constexpr size_t WS_WIN = 1 * MiB, WS_WUPRW = 12 * MiB, WS_WUPNSA = 13 * MiB, WS_WOUT = 14 * MiB, WS_WQ = 16 * MiB, WS_WKV = 18 * MiB, WS_WO = 22 * MiB,
                 WS_WGU = 24 * MiB, WS_WDOWN = 35 * MiB, WS_LORA_W = 41 * MiB, WS_LORA_A = 41 * MiB + 65536, WS_LORA_G = 41 * MiB + 131072,
                 WS_CK1T = 42 * MiB, WS_CV1T = 42 * MiB + 524288, WS_CK2T = 43 * MiB, WS_CV2T = 43 * MiB + 16384, WS_ROPE = 44 * MiB,
                 WS_KCMP = 45 * MiB, WS_VCMPT = 45 * MiB + 524288, WS_SELM = 46 * MiB,
                 WS_XN = 48 * MiB, WS_PRW = 112 * MiB, WS_Q = 224 * MiB, WS_KV6 = 256 * MiB, WS_GN = 304 * MiB, WS_GM = 306 * MiB,
                 WS_VST = 434 * MiB, WS_VWT = 442 * MiB, WS_MEMN = 450 * MiB, WS_KX = 458 * MiB, WS_VXT = 466 * MiB, WS_G = 477 * MiB,
                 WS_SKK = 48 * MiB, WS_SKKA = 80 * MiB, WS_Y = 112 * MiB, WS_ONSA = 144 * MiB, WS_T1 = 48 * MiB, WS_XN2 = 112 * MiB,
                 WS_QX = 176 * MiB, WS_OX = 48 * MiB, WS_HFF = 176 * MiB, WS_SSQ = 509 * MiB, WS_NEED = 512 * MiB;
constexpr size_t DO_SR = 0, DO_SLD = 32 * MiB, DO_SK = 64 * MiB, DO_SV = 96 * MiB;
constexpr int LDS_BYTES = 147456;

struct Prm { const float* in[33]; float* out; unsigned char* ws; };

__device__ __forceinline__ float bf_lo(unsigned u) { return __uint_as_float(u << 16); }
__device__ __forceinline__ float bf_hi(unsigned u) { return __uint_as_float(u & 0xffff0000u); }
__device__ __forceinline__ float bf1(bf16_t v) { return __uint_as_float((unsigned)v << 16); }
__device__ __forceinline__ unsigned f2bf(float f) { unsigned u = __float_as_uint(f); return (u + 0x7fffu + ((u >> 16) & 1u)) >> 16; }
typedef __bf16 bf16x2_hw __attribute__((ext_vector_type(2)));
__device__ __forceinline__ unsigned pk2(float lo, float hi) { const f32x2 v = {lo, hi}; return __builtin_bit_cast(unsigned, __builtin_convertvector(v, bf16x2_hw)); }
__device__ __forceinline__ u32x4 ld16(const void* p) { return *(const u32x4*)p; }
__device__ __forceinline__ u32x2 ld8(const void* p) { return *(const u32x2*)p; }
__device__ __forceinline__ void unpack8(u32x4 v, float (&f)[8]) { f[0] = bf_lo(v.x); f[1] = bf_hi(v.x); f[2] = bf_lo(v.y); f[3] = bf_hi(v.y); f[4] = bf_lo(v.z); f[5] = bf_hi(v.z); f[6] = bf_lo(v.w); f[7] = bf_hi(v.w); }
__device__ __forceinline__ void unpack4(u32x2 v, float (&f)[4]) { f[0] = bf_lo(v.x); f[1] = bf_hi(v.x); f[2] = bf_lo(v.y); f[3] = bf_hi(v.y); }
__device__ __forceinline__ bf16x8 pack8(const float (&f)[8]) { u32x4 v; v.x = pk2(f[0], f[1]); v.y = pk2(f[2], f[3]); v.z = pk2(f[4], f[5]); v.w = pk2(f[6], f[7]); return __builtin_bit_cast(bf16x8, v); }
__device__ __forceinline__ u32x2 pack4(float a, float b, float c, float d) { u32x2 v; v.x = pk2(a, b); v.y = pk2(c, d); return v; }
__device__ __forceinline__ bf16x8 frag_from(u32x4 v) { return __builtin_bit_cast(bf16x8, v); }
__device__ __forceinline__ bf16x8 frag_from2(u32x2 lo, u32x2 hi) { u32x4 v; v.x = lo.x; v.y = lo.y; v.z = hi.x; v.w = hi.y; return __builtin_bit_cast(bf16x8, v); }
__device__ __forceinline__ bf16x8 frag_pk(f32x4 a, f32x4 b) { u32x4 v; v.x = pk2(a[0], a[1]); v.y = pk2(a[2], a[3]); v.z = pk2(b[0], b[1]); v.w = pk2(b[2], b[3]); return __builtin_bit_cast(bf16x8, v); }
__device__ __forceinline__ float qmax(float x) {
    auto a = __builtin_amdgcn_permlane16_swap(__float_as_uint(x), __float_as_uint(x), false, false); x = fmaxf(__uint_as_float(a[0]), __uint_as_float(a[1]));
    auto b = __builtin_amdgcn_permlane32_swap(__float_as_uint(x), __float_as_uint(x), false, false); return fmaxf(__uint_as_float(b[0]), __uint_as_float(b[1]));
}
__device__ __forceinline__ float qsum(float x) {
    auto a = __builtin_amdgcn_permlane16_swap(__float_as_uint(x), __float_as_uint(x), false, false); x = __uint_as_float(a[0]) + __uint_as_float(a[1]);
    auto b = __builtin_amdgcn_permlane32_swap(__float_as_uint(x), __float_as_uint(x), false, false); return __uint_as_float(b[0]) + __uint_as_float(b[1]);
}
#define MFMA16(a, b, c) __builtin_amdgcn_mfma_f32_16x16x32_bf16((a), (b), (c), 0, 0, 0)
__device__ __forceinline__ float sigm(float x) { return __builtin_amdgcn_rcpf(1.0f + __expf(-x)); }
__device__ __forceinline__ float tanh_f(float x) { const float e = __expf(2.0f * x); return 1.0f - 2.0f * __builtin_amdgcn_rcpf(e + 1.0f); }
__device__ __forceinline__ float wave_sum(float v) {
#pragma unroll
    for (int o = 1; o < 64; o <<= 1) v += __shfl_xor(v, o);
    return v;
}
template <int CTRL> __device__ __forceinline__ float dpp_mov(float x) { return __int_as_float(__builtin_amdgcn_update_dpp(0, __float_as_int(x), CTRL, 0xf, 0xf, true)); }
__device__ __forceinline__ float red16(float x) {
    x += dpp_mov<0xB1>(x); x += dpp_mov<0x4E>(x); x += dpp_mov<0x141>(x); x += dpp_mov<0x140>(x); return x;
}

__device__ __forceinline__ void red16_pair(float a, float b, bool odd, float& ra, float& rb) {
    const float keep = odd ? b : a, give = odd ? a : b;
    float q = keep + dpp_mov<0xB1>(give);
    q += dpp_mov<0x4E>(q);
    q += dpp_mov<0x124>(q);
    q += dpp_mov<0x128>(q);
    ra = dpp_mov<0x00>(q);
    rb = dpp_mov<0x55>(q);
}
__device__ __forceinline__ float red16_pair_nb(float a, float b, bool odd) {
    const float keep = odd ? b : a, give = odd ? a : b;
    float q = keep + dpp_mov<0xB1>(give); q += dpp_mov<0x4E>(q); q += dpp_mov<0x124>(q); q += dpp_mov<0x128>(q); return q;
}
#define EPI_LOOP(...) _Pragma("unroll") for (int ai = 0; ai < 2; ++ai) _Pragma("unroll") for (int m = 0; m < 4; ++m) { const int row = u.pm * 256 + ai * 128 + wr * 64 + m * 16 + fr; \
    _Pragma("unroll") for (int bj = 0; bj < 2; ++bj) _Pragma("unroll") for (int n = 0; n < 2; ++n) { const int lc = bj * 128 + wc * 32 + 8 * fq + 4 * n; const f32x4 a = acc[ai][bj][m][n]; __VA_ARGS__ } }

#define EPI2_LOOP(...) _Pragma("unroll") for (int ai = 0; ai < 2; ++ai) _Pragma("unroll") for (int m = 0; m < 4; ++m) { const int row = u.pm * 256 + ai * 128 + wr * 64 + m * 16 + fr; \
    _Pragma("unroll") for (int bj = 0; bj < 2; ++bj) { const int lc = bj * 128 + wc * 32 + 8 * fq; const f32x4 a0 = acc[ai][bj][m][0], a1 = acc[ai][bj][m][1]; __VA_ARGS__ } }
__device__ __forceinline__ u32x4 pack8v(f32x4 a, f32x4 b) { u32x4 v; v.x = pk2(a[0], a[1]); v.y = pk2(a[2], a[3]); v.z = pk2(b[0], b[1]); v.w = pk2(b[2], b[3]); return v; }
__device__ __forceinline__ f32x4 sigm4(f32x4 v) { return (f32x4){sigm(v[0]), sigm(v[1]), sigm(v[2]), sigm(v[3])}; }
struct EpiInProj {
    static constexpr bool PERM = true, AFTER_DRAIN = false;
    bf16_t *prw, *q, *kv6, *gm, *gn;
    __device__ __forceinline__ void operator()(const f32x4 (&acc)[2][2][4][2], const pg8::Unit& u, int wr, int wc, int fr, int fq) const {
        bf16_t* base; int pitch, c0; bool sg = false;
        const int pn = u.pn;
        if (pn < 7) { base = prw; pitch = 1792; c0 = pn * 256; }
        else if (pn < 9) { base = q; pitch = 512; c0 = (pn - 7) * 256; }
        else if (pn < 12) { base = kv6; pitch = 768; c0 = (pn - 9) * 256; }
        else if (pn < 20) { base = gm; pitch = 2048; c0 = (pn - 12) * 256; sg = true; }
        else { base = gn; pitch = 32; c0 = 0; sg = true; }
        EPI2_LOOP({
            if (pn < 20 || lc < 32) { *(u32x4*)(base + (size_t)row * pitch + c0 + lc) = sg ? pack8v(sigm4(a0), sigm4(a1)) : pack8v(a0, a1); }
        })
    }
};
struct EpiBf16 {
    static constexpr bool PERM = true, AFTER_DRAIN = false;
    bf16_t* o; int pitch;
    __device__ __forceinline__ void operator()(const f32x4 (&acc)[2][2][4][2], const pg8::Unit& u, int wr, int wc, int fr, int fq) const {
        EPI_LOOP({ *(u32x2*)(o + (size_t)row * pitch + u.pn * 256 + lc) = pack4(a[0], a[1], a[2], a[3]); })
    }
};
struct EpiMemK {
    static constexpr bool PERM = true, AFTER_DRAIN = false;
    bf16_t* kx;
    __device__ __forceinline__ void operator()(const f32x4 (&acc)[2][2][4][2], const pg8::Unit& u, int wr, int wc, int fr, int fq) const {
        EPI2_LOOP({ *(u32x4*)(kx + (size_t)row * 1024 + u.pn * 256 + lc) = pack8v(a0, a1); })
    }
};
struct EpiMemVT {
    static constexpr bool PERM = true, AFTER_DRAIN = false;
    bf16_t* vxt;
    __device__ __forceinline__ void operator()(const f32x4 (&acc)[2][2][4][2], const pg8::Unit& u, int wr, int wc, int fr, int fq) const {
        bf16_t* base = vxt + (size_t)(u.pn * 4 + u.pm) * 256 * 256;
#pragma unroll
        for (int ai = 0; ai < 2; ++ai)
#pragma unroll
            for (int m = 0; m < 4; ++m) { const int d = ai * 128 + wr * 64 + m * 16 + fr;
#pragma unroll
                for (int bj = 0; bj < 2; ++bj) *(u32x4*)(base + (size_t)d * 256 + bj * 128 + wc * 32 + 8 * fq) = pack8v(acc[ai][bj][m][0], acc[ai][bj][m][1]); }
    }
};
struct EpiGate1 {
    static constexpr bool PERM = true, AFTER_DRAIN = false;
    const bf16_t* gm; bf16_t* t1;
    __device__ __forceinline__ void operator()(const f32x4 (&acc)[2][2][4][2], const pg8::Unit& u, int wr, int wc, int fr, int fq) const {
        EPI2_LOOP({ const int c = u.pn * 256 + lc; float g[8]; unpack8(ld16(gm + (size_t)row * 2048 + c), g);
            *(u32x4*)(t1 + (size_t)row * 1024 + c) = pack8v((f32x4){g[0] * a0[0], g[1] * a0[1], g[2] * a0[2], g[3] * a0[3]}, (f32x4){g[4] * a1[0], g[5] * a1[1], g[6] * a1[2], g[7] * a1[3]}); })
    }
};
struct EpiGate2 {
    static constexpr bool PERM = true, AFTER_DRAIN = false;
    const bf16_t* gm; bf16_t* t1;
    __device__ __forceinline__ void operator()(const f32x4 (&acc)[2][2][4][2], const pg8::Unit& u, int wr, int wc, int fr, int fq) const {
        EPI2_LOOP({ const int c = u.pn * 256 + lc; float g[8], t[8]; unpack8(ld16(gm + (size_t)row * 2048 + 1024 + c), g); unpack8(ld16(t1 + (size_t)row * 1024 + c), t);
            *(u32x4*)(t1 + (size_t)row * 1024 + c) = pack8v((f32x4){t[0] + g[0] * a0[0], t[1] + g[1] * a0[1], t[2] + g[2] * a0[2], t[3] + g[3] * a0[3]}, (f32x4){t[4] + g[4] * a1[0], t[5] + g[5] * a1[1], t[6] + g[6] * a1[2], t[7] + g[7] * a1[3]}); })
    }
};
struct EpiResid {
    static constexpr bool PERM = true, AFTER_DRAIN = false;
    const float* res; float* out;
    __device__ __forceinline__ void operator()(const f32x4 (&acc)[2][2][4][2], const pg8::Unit& u, int wr, int wc, int fr, int fq) const {
        EPI_LOOP({ const size_t o = (size_t)row * 1024 + u.pn * 256 + lc; const f32x4 r = *(const f32x4*)(res + o); *(f32x4*)(out + o) = r + a; })
    }
};
__device__ __forceinline__ float row_rs(const float* ssq, int row) {
    const f32x4* s = (const f32x4*)(ssq + (size_t)row * 16); const f32x4 a = s[0] + s[1] + s[2] + s[3];
    return rsqrtf(((a[0] + a[1]) + (a[2] + a[3])) * (1.0f / DM) + 1e-6f);
}
__device__ __forceinline__ float row_rs_q(const float* ssq, int row, int fq) {
    const f32x4 a = ((const f32x4*)(ssq + (size_t)row * 16))[fq];
    return rsqrtf(qsum((a[0] + a[1]) + (a[2] + a[3])) * (1.0f / DM) + 1e-6f);
}
struct EpiResid2 {
    static constexpr bool PERM = true, AFTER_DRAIN = false;
    const float* res; float* out; bf16_t* hb; float* ssq;
    __device__ __forceinline__ void operator()(const f32x4 (&acc)[2][2][4][2], const pg8::Unit& u, int wr, int wc, int fr, int fq) const {
#pragma unroll
        for (int ai = 0; ai < 2; ++ai)
#pragma unroll
            for (int m = 0; m < 4; ++m) { const int row = u.pm * 256 + ai * 128 + wr * 64 + m * 16 + fr; float ss = 0.f;
#pragma unroll
                for (int bj = 0; bj < 2; ++bj)
#pragma unroll
                    for (int n = 0; n < 2; ++n) { const size_t o = (size_t)row * 1024 + u.pn * 256 + bj * 128 + wc * 32 + 8 * fq + 4 * n;
                        const f32x4 v = *(const f32x4*)(res + o) + acc[ai][bj][m][n]; *(f32x4*)(out + o) = v; *(u32x2*)(hb + o) = pack4(v[0], v[1], v[2], v[3]);
                        ss += (v[0] * v[0] + v[1] * v[1]) + (v[2] * v[2] + v[3] * v[3]); }
                ss = qsum(ss);
                if (fq == 0) ssq[(size_t)row * 16 + u.pn * 4 + wc] = ss; }
    }
};
struct EpiBf16S {
    static constexpr bool PERM = true, AFTER_DRAIN = false;
    bf16_t* o; int pitch; const float* ssq;
    __device__ __forceinline__ void operator()(const f32x4 (&acc)[2][2][4][2], const pg8::Unit& u, int wr, int wc, int fr, int fq) const {
#pragma unroll
        for (int ai = 0; ai < 2; ++ai)
#pragma unroll
            for (int m = 0; m < 4; ++m) { const int row = u.pm * 256 + ai * 128 + wr * 64 + m * 16 + fr; const float rs = row_rs_q(ssq, row, fq);
#pragma unroll
                for (int bj = 0; bj < 2; ++bj) *(u32x4*)(o + (size_t)row * pitch + u.pn * 256 + bj * 128 + wc * 32 + 8 * fq) = pack8v(acc[ai][bj][m][0] * rs, acc[ai][bj][m][1] * rs); }
    }
};
struct EpiResidH {
    static constexpr bool PERM = true, AFTER_DRAIN = false;
    const float* resf; const bf16_t* resb; bf16_t* hb; float* ssq;
    __device__ __forceinline__ void operator()(const f32x4 (&acc)[2][2][4][2], const pg8::Unit& u, int wr, int wc, int fr, int fq) const {
#pragma unroll
        for (int ai = 0; ai < 2; ++ai)
#pragma unroll
            for (int m = 0; m < 4; ++m) { const int row = u.pm * 256 + ai * 128 + wr * 64 + m * 16 + fr; float ss = 0.f;
#pragma unroll
                for (int bj = 0; bj < 2; ++bj) { const size_t o = (size_t)row * 1024 + u.pn * 256 + bj * 128 + wc * 32 + 8 * fq;
                    f32x4 r0, r1;
                    if (resf) { r0 = *(const f32x4*)(resf + o); r1 = *(const f32x4*)(resf + o + 4); }
                    else { float t[8]; unpack8(ld16(resb + o), t); r0 = (f32x4){t[0], t[1], t[2], t[3]}; r1 = (f32x4){t[4], t[5], t[6], t[7]}; }
                    const f32x4 v0 = r0 + acc[ai][bj][m][0], v1 = r1 + acc[ai][bj][m][1];
                    *(u32x4*)(hb + o) = pack8v(v0, v1);
                    ss += ((v0[0] * v0[0] + v0[1] * v0[1]) + (v0[2] * v0[2] + v0[3] * v0[3])) + ((v1[0] * v1[0] + v1[1] * v1[1]) + (v1[2] * v1[2] + v1[3] * v1[3])); }
                ss = qsum(ss);
                if (fq == 0) ssq[(size_t)row * 16 + u.pn * 4 + wc] = ss; }
    }
};
struct EpiResidB {
    static constexpr bool PERM = true, AFTER_DRAIN = false;
    const float* res; bf16_t* hb; float* ssq;
    __device__ __forceinline__ void operator()(const f32x4 (&acc)[2][2][4][2], const pg8::Unit& u, int wr, int wc, int fr, int fq) const {
#pragma unroll
        for (int ai = 0; ai < 2; ++ai)
#pragma unroll
            for (int m = 0; m < 4; ++m) { const int row = u.pm * 256 + ai * 128 + wr * 64 + m * 16 + fr; float ss = 0.f;
#pragma unroll
                for (int bj = 0; bj < 2; ++bj) { const size_t o = (size_t)row * 1024 + u.pn * 256 + bj * 128 + wc * 32 + 8 * fq;
                    const f32x4 v0 = *(const f32x4*)(res + o) + acc[ai][bj][m][0], v1 = *(const f32x4*)(res + o + 4) + acc[ai][bj][m][1];
                    *(u32x4*)(hb + o) = pack8v(v0, v1);
                    ss += ((v0[0] * v0[0] + v0[1] * v0[1]) + (v0[2] * v0[2] + v0[3] * v0[3])) + ((v1[0] * v1[0] + v1[1] * v1[1]) + (v1[2] * v1[2] + v1[3] * v1[3])); }
                ss = qsum(ss);
                if (fq == 0) ssq[(size_t)row * 16 + u.pn * 4 + wc] = ss; }
    }
};
struct EpiSwiglu {
    static constexpr bool PERM = true, AFTER_DRAIN = false;
    bf16_t* h; const float* ssq;
    __device__ __forceinline__ void operator()(const f32x4 (&acc)[2][2][4][2], const pg8::Unit& u, int wr, int wc, int fr, int fq) const {
#pragma unroll
        for (int ai = 0; ai < 2; ++ai)
#pragma unroll
            for (int m = 0; m < 4; ++m) { const int row = u.pm * 256 + ai * 128 + wr * 64 + m * 16 + fr; const float rs = row_rs_q(ssq, row, fq);
                f32x4 hv[2];
#pragma unroll
                for (int n = 0; n < 2; ++n) { const f32x4 g = acc[ai][0][m][n] * rs, uu = acc[ai][1][m][n] * rs;
                    hv[n] = (f32x4){g[0] * sigm(g[0]) * uu[0], g[1] * sigm(g[1]) * uu[1], g[2] * sigm(g[2]) * uu[2], g[3] * sigm(g[3]) * uu[3]}; }
                *(u32x4*)(h + (size_t)row * DFF + u.pn * 128 + wc * 32 + 8 * fq) = pack8v(hv[0], hv[1]); }
    }
};

template <class Epi> __device__ __forceinline__ void run_gemm(LAS unsigned char* lds, const bf16_t* A, const bf16_t* Bt, int M, int N, int K, const Epi& E, int rot = 0) {
    pg8::Gemm g{A, Bt, M, N, K}; pg8::StaticOrder S; S.init(M, N, (int)gridDim.x, (int)((blockIdx.x + rot) % gridDim.x));
    pg8::gemm_phase<Epi, pg8::StaticOrder, true, true>(lds, g, S, E);
}

__device__ __forceinline__ int rowmap(int mode, int n) {
    if (mode == 1) { if (n < 3072) return n; if (n < 3096) return 5120 + (n - 3072); return 3072 + (n - 3096); }
    if (mode == 2) { const int j = n < DFF ? n : n - DFF; return (j >> 7) * 256 + (n < DFF ? 0 : 128) + (j & 127); }
    return n;
}
__device__ __forceinline__ void transpose_w(const float* W, int K, int N, bf16_t* WT, int mode, LAS float* scr, int lane, int& off, int NGW, const float* ks = nullptr) {
    const int nblk = (N + 31) >> 5, nitems = (K >> 6) * nblk; int it = off;
    for (; it < nitems; it += NGW) {
        const int kb = it / nblk, nb = it - kb * nblk, k0 = kb * 64, n0 = nb * 32;
        float tv[32];
#pragma unroll
        for (int i = 0; i < 32; ++i) { const int kk = 2 * i + (lane >> 5), n = n0 + (lane & 31); tv[i] = (n < N) ? W[(size_t)(k0 + kk) * N + n] * (ks ? ks[k0 + kk] : 1.0f) : 0.f; }
#pragma unroll
        for (int i = 0; i < 32; ++i) { const int kk = 2 * i + (lane >> 5); scr[kk * 33 + (lane & 31)] = tv[i]; }
        asm volatile("s_waitcnt lgkmcnt(0)" ::: "memory");
        const int c = lane & 7;
#pragma unroll
        for (int j = 0; j < 4; ++j) { const int nl = (lane >> 3) + 8 * j, n = n0 + nl; const LAS float* s = scr + (8 * c) * 33 + nl;
            if (n < N) { u32x4 o; o.x = pk2(s[0], s[33]); o.y = pk2(s[66], s[99]); o.z = pk2(s[132], s[165]); o.w = pk2(s[198], s[231]);
                *(u32x4*)(WT + (size_t)rowmap(mode, n) * K + k0 + 8 * c) = o; } }
        asm volatile("s_waitcnt lgkmcnt(0)" ::: "memory");
    }
    off = it - nitems;
}
__device__ __forceinline__ void norm_rows(const float* src, const float* gain, bf16_t* dst, int rows, int lane, int gw, int NGW) {
    for (int m0 = gw; m0 < rows; m0 += 2 * NGW) {
        const int m1 = m0 + NGW; const bool h1 = m1 < rows;
        const f32x4* xa = (const f32x4*)(src + (size_t)m0 * DM) + lane; const f32x4* xb = (const f32x4*)(src + (size_t)(h1 ? m1 : m0) * DM) + lane; f32x4 va[4], vb[4]; float sa = 0.f, sb = 0.f;
#pragma unroll
        for (int j = 0; j < 4; ++j) { va[j] = xa[64 * j]; vb[j] = xb[64 * j]; }
#pragma unroll
        for (int j = 0; j < 4; ++j) { sa += (va[j][0] * va[j][0] + va[j][1] * va[j][1]) + (va[j][2] * va[j][2] + va[j][3] * va[j][3]); sb += (vb[j][0] * vb[j][0] + vb[j][1] * vb[j][1]) + (vb[j][2] * vb[j][2] + vb[j][3] * vb[j][3]); }
#pragma unroll
        for (int o = 1; o < 64; o <<= 1) { sa += __shfl_xor(sa, o); sb += __shfl_xor(sb, o); }
        const float ra = rsqrtf(sa * (1.0f / DM) + 1e-6f), rb = rsqrtf(sb * (1.0f / DM) + 1e-6f);
#pragma unroll
        for (int j = 0; j < 4; ++j) { const f32x4 g = ((const f32x4*)gain)[lane + 64 * j];
            *(u32x2*)(dst + (size_t)m0 * DM + 4 * (lane + 64 * j)) = pack4(va[j][0] * ra * g[0], va[j][1] * ra * g[1], va[j][2] * ra * g[2], va[j][3] * ra * g[3]);
            if (h1) *(u32x2*)(dst + (size_t)m1 * DM + 4 * (lane + 64 * j)) = pack4(vb[j][0] * rb * g[0], vb[j][1] * rb * g[1], vb[j][2] * rb * g[2], vb[j][3] * rb * g[3]); }
    }
}

__device__ __forceinline__ u32x4 lds_ld16(LAS unsigned char* p);
__device__ __forceinline__ void sh8(const bf16_t* cur, const bf16_t* prv, bool hp, const float* mu, int c, float (&o)[8]) {
    float a[8], b[8]; unpack8(ld16(cur + c), a); unpack8(ld16((hp ? prv : cur) + c), b);
    const f32x4 m0 = *(const f32x4*)(mu + c), m1 = *(const f32x4*)(mu + c + 4);
#pragma unroll
    for (int i = 0; i < 4; ++i) { const float b0 = hp ? b[i] : 0.f, b1 = hp ? b[4 + i] : 0.f; o[i] = a[i] + m0[i] * (b0 - a[i]); o[4 + i] = a[4 + i] + m1[i] * (b1 - a[4 + i]); }
}
__device__ __forceinline__ void sh4(const bf16_t* cur, const bf16_t* prv, bool hp, const float* mu, int c, float (&o)[4]) {
    float a[4], b[4]; unpack4(ld8(cur + c), a);
    if (hp) unpack4(ld8(prv + c), b); else { b[0] = b[1] = b[2] = b[3] = 0.f; }
    const f32x4 m0 = *(const f32x4*)(mu + c);
#pragma unroll
    for (int i = 0; i < 4; ++i) o[i] = a[i] + m0[i] * (b[i] - a[i]);
}
__device__ __forceinline__ void sh8r(u32x4 rc, u32x4 rp, bool hp, const LAS float* mul, float (&o)[8]) {
    float a[8], b[8]; unpack8(rc, a); unpack8(rp, b);
    const f32x4 m0 = *(const LAS f32x4*)(mul), m1 = *(const LAS f32x4*)(mul + 4);
#pragma unroll
    for (int i = 0; i < 4; ++i) { const float b0 = hp ? b[i] : 0.f, b1 = hp ? b[4 + i] : 0.f; o[i] = a[i] + m0[i] * (b0 - a[i]); o[4 + i] = a[4 + i] + m1[i] * (b1 - a[4 + i]); }
}
__device__ __forceinline__ void rw_prep_task(const Prm& p, LAS unsigned char* lds, int tt, int tid, int wave, int lane) {
    const int tk = lane & 15, q = lane >> 4;
    const int bt = tt * 16 + tk; const bool hp = (bt & (SEQ - 1)) > 0;
    const bf16_t* cur = (const bf16_t*)(p.ws + WS_PRW) + (size_t)bt * 1792; const bf16_t* prv = hp ? cur - 1792 : cur;
    const float* mu = p.in[4];
    const bf16_t* Ww = (const bf16_t*)(p.ws + WS_LORA_W); const bf16_t* Wa = (const bf16_t*)(p.ws + WS_LORA_A); const bf16_t* Wg = (const bf16_t*)(p.ws + WS_LORA_G);
    bf16_t* SR = (bf16_t*)((unsigned char*)p.out + DO_SR); bf16_t* SLD = (bf16_t*)((unsigned char*)p.out + DO_SLD); bf16_t* SK = (bf16_t*)((unsigned char*)p.out + DO_SK); bf16_t* SV = (bf16_t*)((unsigned char*)p.out + DO_SV);
    bf16_t* SKK = (bf16_t*)(p.ws + WS_SKK); bf16_t* SKKA = (bf16_t*)(p.ws + WS_SKKA); bf16_t* SG = (bf16_t*)(p.ws + WS_G);
    LAS float* lpar = (LAS float*)(lds + 36864); LAS float* lmu = (LAS float*)(lds + 45056); LAS unsigned char* lfr = lds + 52224 + wave * 8192 + lane * 16;
    __syncthreads();
    for (int i = tid; i < 2048; i += 512) { const int wh = i >> 9, ix = i & 511; lpar[i] = (wh == 0 ? p.in[6] : wh == 1 ? p.in[8] : wh == 2 ? p.in[10] : p.in[11])[ix]; }
    for (int i = tid; i < 1792; i += 512) lmu[i] = mu[i];
#pragma unroll
    for (int s = 0; s < 2; ++s) { float f[8]; sh8(cur, prv, hp, mu, 1536 + 32 * s + 8 * q, f);
#pragma unroll
        for (int i = 0; i < 8; ++i) f[i] = tanh_f(f[i]);
        *(LAS u32x4*)(lfr + s * 1024) = __builtin_bit_cast(u32x4, pack8(f)); }
#pragma unroll
    for (int s = 0; s < 2; ++s) { float f[8]; sh8(cur, prv, hp, mu, 1600 + 32 * s + 8 * q, f); *(LAS u32x4*)(lfr + (2 + s) * 1024) = __builtin_bit_cast(u32x4, pack8(f)); }
#pragma unroll
    for (int s = 0; s < 4; ++s) { float f[8]; sh8(cur, prv, hp, mu, 1664 + 32 * s + 8 * q, f);
#pragma unroll
        for (int i = 0; i < 8; ++i) f[i] = sigm(f[i]);
        *(LAS u32x4*)(lfr + (4 + s) * 1024) = __builtin_bit_cast(u32x4, pack8(f)); }
#pragma unroll 1
    for (int h = 0; h < 8; ++h) {
        u32x4 raw[2][6];
#pragma unroll
        for (int u = 0; u < 2; ++u) { const int c8 = h * 64 + 32 * u + 8 * q;
            raw[u][0] = ld16(cur + c8); raw[u][1] = ld16(prv + c8); raw[u][2] = ld16(cur + 512 + c8); raw[u][3] = ld16(prv + 512 + c8); raw[u][4] = ld16(cur + 1024 + c8); raw[u][5] = ld16(prv + 1024 + c8); }
        __syncthreads();
#pragma unroll
        for (int i = 0; i < 4; ++i) { const int idx = tid + 512 * i;
            if (idx < 512) *(LAS u32x4*)(lds + (idx >> 3) * 144 + (idx & 7) * 16) = ld16(Ww + (size_t)(h * 64 + (idx >> 3)) * 64 + (idx & 7) * 8);
            else if (idx < 1024) { const int j = idx - 512; *(LAS u32x4*)(lds + 9216 + (j >> 3) * 144 + (j & 7) * 16) = ld16(Wa + (size_t)(h * 64 + (j >> 3)) * 64 + (j & 7) * 8); }
            else { const int j = idx - 1024; *(LAS u32x4*)(lds + 18432 + (j >> 4) * 272 + (j & 15) * 16) = ld16(Wg + (size_t)(h * 64 + (j >> 4)) * 128 + (j & 15) * 8); } }
        __syncthreads();
        float kkr[4][4], av[4][4]; float ss = 0.f;
#define ST8(P, A, B) *(u32x4*)((P) + o) = (u32x4){pk2((A)[0], (A)[1]), pk2((A)[2], (A)[3]), pk2((B)[0], (B)[1]), pk2((B)[2], (B)[3])}
#pragma unroll
        for (int u = 0; u < 2; ++u) {
            const int c8 = h * 64 + 32 * u + 8 * q;
            float r8[8], k8[8], v8[8], kxl[8], gvl[8];
            sh8r(raw[u][0], raw[u][1], hp, lmu + c8, r8); sh8r(raw[u][2], raw[u][3], hp, lmu + 512 + c8, k8); sh8r(raw[u][4], raw[u][5], hp, lmu + 1024 + c8, v8);
#pragma unroll
            for (int e = 0; e < 2; ++e) {
                const int ct = 2 * u + e;
                const int rowl = 32 * u + 4 * e + 8 * (tk >> 2) + (tk & 3);
                f32x4 accw = {0.f, 0.f, 0.f, 0.f}, acca = {0.f, 0.f, 0.f, 0.f}, accg = {0.f, 0.f, 0.f, 0.f};
#pragma unroll
                for (int s = 0; s < 2; ++s) { accw = MFMA16(frag_from(lds_ld16(lds + rowl * 144 + 64 * s + 16 * q)), frag_from(lds_ld16(lfr + s * 1024)), accw);
                    acca = MFMA16(frag_from(lds_ld16(lds + 9216 + rowl * 144 + 64 * s + 16 * q)), frag_from(lds_ld16(lfr + (2 + s) * 1024)), acca); }
#pragma unroll
                for (int s = 0; s < 4; ++s) accg = MFMA16(frag_from(lds_ld16(lds + 18432 + rowl * 272 + 64 * s + 16 * q)), frag_from(lds_ld16(lfr + (4 + s) * 1024)), accg);
                const int c = c8 + 4 * e;
                const f32x4 w0v = *(const LAS f32x4*)(lpar + c), a0v = *(const LAS f32x4*)(lpar + 512 + c), kkv = *(const LAS f32x4*)(lpar + 1024 + c), kav = *(const LAS f32x4*)(lpar + 1536 + c);
                float ldl[4];
#pragma unroll
                for (int j = 0; j < 4; ++j) {
                    const float wl = w0v[j] + accw[j]; const float z = -wl;
                    const float sp = fmaxf(z, 0.f) + __logf(1.0f + __expf(-fabsf(z)));
                    ldl[j] = -__expf(-sp - 0.5f);
                    const float a = sigm(a0v[j] + acca[j]); av[ct][j] = a; gvl[4 * e + j] = accg[j];
                    const float kk = k8[4 * e + j] * kkv[j]; kkr[ct][j] = kk; ss += kk * kk;
                    kxl[4 * e + j] = k8[4 * e + j] * (1.0f + (a - 1.0f) * kav[j]);
                }
                *(u32x2*)(SLD + (size_t)bt * 512 + c) = pack4(ldl[0], ldl[1], ldl[2], ldl[3]);
            }
            const size_t o = (size_t)bt * 512 + c8;
            *(u32x4*)(SR + o) = __builtin_bit_cast(u32x4, pack8(r8)); *(u32x4*)(SV + o) = __builtin_bit_cast(u32x4, pack8(v8));
            *(u32x4*)(SK + o) = __builtin_bit_cast(u32x4, pack8(kxl)); *(u32x4*)(SG + o) = __builtin_bit_cast(u32x4, pack8(gvl));
        }
        ss = qsum(ss);
        const float inv = rsqrtf(fmaxf(ss, 1e-12f));
#pragma unroll
        for (int u = 0; u < 2; ++u) { const size_t o = (size_t)bt * 512 + h * 64 + 32 * u + 8 * q; const int c0 = 2 * u, c1 = 2 * u + 1;
            float ka[4], kb[4], aa[4], ab[4];
#pragma unroll
            for (int j = 0; j < 4; ++j) { ka[j] = kkr[c0][j] * inv; kb[j] = kkr[c1][j] * inv; aa[j] = ka[j] * av[c0][j]; ab[j] = kb[j] * av[c1][j]; }
            ST8(SKK, ka, kb); ST8(SKKA, aa, ab);
        }
#undef ST8
    }
}

__device__ __forceinline__ float gelu_t(float x) { return 0.5f * x * (1.0f + tanh_f(0.7978845608028654f * (x + 0.044715f * x * x * x))); }
__device__ __forceinline__ void compress_wg_task(const Prm& p, LAS unsigned char* lds, int wt, int wave, int lane) {
    const int st = wave >> 2, hq = wave & 3, task = wt * 2 + st;
    const int which = task / 254, tile = task - which * 254, tk = lane & 15, q = lane >> 4;
    const int row = tile * 16 + tk; const int b = row / 254, rem = row - b * 254, n = rem >> 1, g = rem & 1;
    const bf16_t* KV6 = (const bf16_t*)(p.ws + WS_KV6); const float* pe = which ? p.in[16] : p.in[15];
    const bf16_t* W1 = (const bf16_t*)(p.ws + (which ? WS_CV1T : WS_CK1T)) + (size_t)(32 * hq + tk) * 2048 + 8 * q; const bf16_t* W2 = (const bf16_t*)(p.ws + (which ? WS_CV2T : WS_CK2T));
    const bf16_t* src = KV6 + (size_t)(b * SEQ + 16 * n) * 768 + which * 128 + g * 64 + 8 * q;
    f32x4 acc0 = {0.f, 0.f, 0.f, 0.f}, acc1 = {0.f, 0.f, 0.f, 0.f};
#pragma unroll 4
    for (int s = 0; s < 64; ++s) {
        const int l = s >> 1, d = (s & 1) * 32;
        float f[8]; unpack8(ld16(src + (size_t)l * 768 + d), f);
        const f32x4 p0 = *(const f32x4*)(pe + l * 64 + d + 8 * q), p1 = *(const f32x4*)(pe + l * 64 + d + 8 * q + 4);
#pragma unroll
        for (int i = 0; i < 4; ++i) { f[i] += p0[i]; f[4 + i] += p1[i]; }
        const bf16x8 xb = pack8(f);
        acc0 = MFMA16(frag_from(ld16(W1 + 32 * s)), xb, acc0); acc1 = MFMA16(frag_from(ld16(W1 + 16 * 2048 + 32 * s)), xb, acc1);
    }
#pragma unroll
    for (int j = 0; j < 4; ++j) { acc0[j] = gelu_t(acc0[j]); acc1[j] = gelu_t(acc1[j]); }
    const bf16x8 hb = frag_pk(acc0, acc1);
    LAS float* red = (LAS float*)lds + (st * 4 + hq) * 1024 + lane * 16;
#pragma unroll
    for (int ot = 0; ot < 4; ++ot) { const bf16_t* w = W2 + (16 * ot + tk) * 128 + 32 * hq + 4 * q;
        const f32x4 d2 = MFMA16(frag_from2(ld8(w), ld8(w + 16)), hb, ((f32x4){0.f, 0.f, 0.f, 0.f}));
        *(LAS f32x4*)(red + 4 * ot) = d2; }
    __syncthreads();
    { const int ot = hq; LAS float* rb = (LAS float*)lds + (st * 4) * 1024 + lane * 16 + 4 * ot;
      const f32x4 d2 = *(const LAS f32x4*)rb + *(const LAS f32x4*)(rb + 1024) + *(const LAS f32x4*)(rb + 2048) + *(const LAS f32x4*)(rb + 3072);
      bf16_t* kc = (bf16_t*)(p.ws + WS_KCMP); bf16_t* vct = (bf16_t*)(p.ws + WS_VCMPT); const int o = 16 * ot + 4 * q;
      if (which == 0) *(u32x2*)(kc + ((size_t)((b * 2 + g) * 128 + n)) * 64 + o) = pack4(d2[0], d2[1], d2[2], d2[3]);
      else {
#pragma unroll
          for (int j = 0; j < 4; ++j) vct[((size_t)((b * 2 + g) * 64 + o + j)) * 128 + n] = (bf16_t)f2bf(d2[j]); } }
    __syncthreads();
}

__device__ __forceinline__ u32x4 lds_ld16(LAS unsigned char* p);
__device__ __forceinline__ u32x2 lds_ld8(LAS unsigned char* p);
__device__ __forceinline__ void cmp_attn_task(const Prm& p, LAS unsigned char* kb, LAS unsigned char* vb, int task, int lane) {
    const int tile = task & 127, g = (task >> 7) & 1, b = task >> 8, tk = lane & 15, q = lane >> 4;
    const int t = tile * 16 + tk; const size_t bt = (size_t)b * SEQ + t;
    const bf16_t* Q = (const bf16_t*)(p.ws + WS_Q);
    const bf16_t* GN = (const bf16_t*)(p.ws + WS_GN); bf16_t* ON = (bf16_t*)(p.ws + WS_ONSA);
    f32x4 ps[8];
#pragma unroll
    for (int c = 0; c < 8; ++c) ps[c] = (f32x4){0.f, 0.f, 0.f, 0.f};
    const int nvalid = (t >= 31) ? ((t - 31) >> 4) + 1 : 0;
#pragma unroll 1
    for (int hp = 0; hp < 4; ++hp) {
        const int h = g * 4 + hp;
        float f0[8], f1[8]; unpack8(ld16(Q + bt * 512 + h * 64 + 8 * q), f0); unpack8(ld16(Q + bt * 512 + h * 64 + 32 + 8 * q), f1);
#pragma unroll
        for (int i = 0; i < 8; ++i) { f0[i] *= 0.125f; f1[i] *= 0.125f; }
        const bf16x8 qf0 = pack8(f0), qf1 = pack8(f1);
        f32x4 s[8]; float mx = -1e30f;
#pragma unroll
        for (int c = 0; c < 8; ++c) { LAS unsigned char* kr = kb + (16 * c + tk) * 144 + 16 * q;
            s[c] = MFMA16(frag_from(lds_ld16(kr)), qf0, ((f32x4){0.f, 0.f, 0.f, 0.f})); s[c] = MFMA16(frag_from(lds_ld16(kr + 64)), qf1, s[c]);
#pragma unroll
            for (int j = 0; j < 4; ++j) { const int n = 16 * c + 4 * q + j; if (n < nvalid) mx = fmaxf(mx, s[c][j]); }
            if (c & 1) __builtin_amdgcn_sched_barrier(0); }
        mx = qmax(mx);
        float l = 0.f;
#pragma unroll
        for (int c = 0; c < 8; ++c)
#pragma unroll
            for (int j = 0; j < 4; ++j) { const int n = 16 * c + 4 * q + j; const float e = (n < nvalid) ? __expf(s[c][j] - mx) : 0.f; s[c][j] = e; l += e; }
        l = qsum(l);
        const float il = 1.0f / fmaxf(l, 1e-30f);
#pragma unroll
        for (int c = 0; c < 8; ++c) { s[c] = s[c] * il; ps[c] = ps[c] + s[c]; }
        const float gate = bf1(GN[bt * 32 + h * 3 + 0]);
#pragma unroll
        for (int dt = 0; dt < 4; ++dt) { f32x4 o = {0.f, 0.f, 0.f, 0.f};
#pragma unroll
            for (int s2 = 0; s2 < 4; ++s2) { LAS unsigned char* v = vb + (16 * dt + tk) * 272 + 64 * s2 + 8 * q;
                o = MFMA16(frag_from2(lds_ld8(v), lds_ld8(v + 32)), frag_pk(s[2 * s2], s[2 * s2 + 1]), o); }
            *(u32x2*)(ON + bt * 512 + h * 64 + 16 * dt + 4 * q) = pack4(o[0] * gate, o[1] * gate, o[2] * gate, o[3] * gate); }
    }
    const int src = (lane + 48) & 63, cur = t >> 6;
    float imp[8];
#pragma unroll
    for (int c = 0; c < 8; ++c) {
        const float a = __shfl(ps[c][3], src); const float bb = (c > 0) ? __shfl(ps[c > 0 ? c - 1 : 0][3], src) : 0.f;
        const float prev = (q == 0) ? bb : a; const int j = 4 * c + q;
        float v = 0.5f * prev + ps[c][0] + ps[c][1] + ps[c][2] + 0.5f * ps[c][3];
        if (j == 0 || j == cur || j == cur - 1) v = 1e4f; else if (j > cur) v = -1.0f;
        imp[c] = v;
    }
    int rank[8];
#pragma unroll
    for (int c = 0; c < 8; ++c) rank[c] = 0;
#pragma unroll
    for (int c2 = 0; c2 < 8; ++c2)
#pragma unroll
        for (int q2 = 0; q2 < 4; ++q2) { const float o = __shfl(imp[c2], q2 * 16 + tk); const int j2 = 4 * c2 + q2;
#pragma unroll
            for (int c = 0; c < 8; ++c) { const int j = 4 * c + q; rank[c] += (o > imp[c] || (o == imp[c] && j2 < j)) ? 1 : 0; } }
    unsigned mask = 0u;
#pragma unroll
    for (int c = 0; c < 8; ++c) if (rank[c] < 8) mask |= 1u << (4 * c + q);
    mask |= __shfl_xor(mask, 16); mask |= __shfl_xor(mask, 32);
    if (q == 0) ((unsigned*)(p.ws + WS_SELM))[(size_t)(b * 2 + g) * SEQ + t] = mask;
}

__device__ __forceinline__ u32x4 lds_ld16(LAS unsigned char* p) { return *(const LAS u32x4*)p; }
__device__ __forceinline__ u32x2 lds_ld8(LAS unsigned char* p) { return *(const LAS u32x2*)p; }
__device__ __forceinline__ void nsa_wg_task(const Prm& p, LAS unsigned char* lds, int k, int tid, int wave, int lane, int& it) {
    const int r = k >> 8, w = k & 255, qt = (r & 1) ? 31 - (w & 31) : (w & 31), bg = (w >> 5) + 8 * r, b = bg >> 1, g = bg & 1;
    const int hp = wave & 3, h = g * 4 + hp, th = wave >> 2, tk = lane & 15, q = lane >> 4, t0 = qt * 64, cur = qt;
    const bf16_t* Q = (const bf16_t*)(p.ws + WS_Q); const bf16_t* KV6 = (const bf16_t*)(p.ws + WS_KV6) + (size_t)b * SEQ * 768;
    const bf16_t* GN = (const bf16_t*)(p.ws + WS_GN); bf16_t* ON = (bf16_t*)(p.ws + WS_ONSA);
    const unsigned* SM = (const unsigned*)(p.ws + WS_SELM) + (size_t)bg * SEQ;
    int tq[2]; size_t btq[2]; bf16x8 qf[2][2]; unsigned mym[2];
#pragma unroll
    for (int ct = 0; ct < 2; ++ct) {
        tq[ct] = t0 + th * 32 + ct * 16 + tk; btq[ct] = (size_t)b * SEQ + tq[ct];
        const f32x2* rope = (const f32x2*)(p.ws + WS_ROPE) + tq[ct] * 32 + 8 * q;
        float x1[8], x2[8], o1[8], o2[8]; unpack8(ld16(Q + btq[ct] * 512 + h * 64 + 8 * q), x1); unpack8(ld16(Q + btq[ct] * 512 + h * 64 + 32 + 8 * q), x2);
#pragma unroll
        for (int i = 0; i < 8; ++i) { const f32x2 cs = rope[i]; o1[i] = (x1[i] * cs[0] - x2[i] * cs[1]) * 0.18033688f; o2[i] = (x2[i] * cs[0] + x1[i] * cs[1]) * 0.18033688f; }
        qf[ct][0] = pack8(o1); qf[ct][1] = pack8(o2); mym[ct] = SM[tq[ct]];
    }
    unsigned um = SM[t0 + lane];
#pragma unroll
    for (int o = 1; o < 64; o <<= 1) um |= __shfl_xor(um, o);
    um = __builtin_amdgcn_readfirstlane(um);
    f32x4 out[2][4];
#pragma unroll
    for (int ct = 0; ct < 2; ++ct)
#pragma unroll
        for (int dt = 0; dt < 4; ++dt) out[ct][dt] = (f32x4){0.f, 0.f, 0.f, 0.f};
    const int srow = tid >> 3, sch = tid & 7;
#pragma unroll
    for (int br = 0; br < 2; ++br) {
        const bf16_t* Ksrc = KV6 + (br ? 512 : 256) + g * 64 + (size_t)srow * 768 + sch * 8;
        const bf16_t* Vsrc = (const bf16_t*)(p.ws + (br ? WS_VWT : WS_VST)) + (size_t)bg * 64 * SEQ + (size_t)srow * SEQ + sch * 8;
        unsigned todo = br ? (((cur >= 8) ? (0x1ffu << (cur - 8)) : ((2u << cur) - 1u))) : (um & ((cur == 31) ? 0xffffffffu : ((2u << cur) - 1u)));
        float m[2] = {-1e30f, -1e30f}, l[2] = {0.f, 0.f}; f32x4 o[2][4];
#pragma unroll
        for (int ct = 0; ct < 2; ++ct)
#pragma unroll
            for (int dt = 0; dt < 4; ++dt) o[ct][dt] = (f32x4){0.f, 0.f, 0.f, 0.f};
#define NSA_POP(jv) do { jv = todo ? (int)__builtin_ctz(todo) : -1; if (todo) todo &= todo - 1u; } while (0)
#define NSA_LOAD(jv, kr_, vr_) do { if (jv >= 0) { kr_ = ld16(Ksrc + (size_t)(64 * jv) * 768); vr_ = ld16(Vsrc + 64 * jv); } } while (0)
#define NSA_STEP(jv, kr_, vr_) { if (jv < 0) break; \
            LAS unsigned char* kb = lds + (it & 1) * 18432; LAS unsigned char* vb = kb + 9216; ++it; \
            *(LAS u32x4*)(kb + srow * 144 + sch * 16) = kr_; *(LAS u32x4*)(vb + srow * 144 + sch * 16) = vr_; \
            __syncthreads(); \
            const int jc = jv, k0 = 64 * jc; NSA_POP(jv); NSA_LOAD(jv, kr_, vr_); \
            nsa_compute(kb, vb, jc, k0); }
        auto nsa_compute = [&](LAS unsigned char* kb, LAS unsigned char* vb, const int jc, const int k0) __attribute__((always_inline)) {
            f32x4 s[2][4];
#pragma unroll
            for (int c = 0; c < 4; ++c) { const bf16x8 kf0 = frag_from(lds_ld16(kb + (16 * c + tk) * 144 + 16 * q)), kf1 = frag_from(lds_ld16(kb + (16 * c + tk) * 144 + 64 + 16 * q));
#pragma unroll
                for (int ct = 0; ct < 2; ++ct) { s[ct][c] = MFMA16(kf0, qf[ct][0], ((f32x4){0.f, 0.f, 0.f, 0.f})); s[ct][c] = MFMA16(kf1, qf[ct][1], s[ct][c]); } }
            bf16x8 pf[2][2];
            const bool partial = (jc == cur) || (br == 1 && jc == cur - 8);
#pragma unroll
            for (int ct = 0; ct < 2; ++ct) {
                const int t = tq[ct]; const bool sel = br ? true : (((mym[ct] >> jc) & 1u) != 0u); float bm = -1e30f, ls = 0.f, mn, sc;
                if (partial) {
#pragma unroll
                    for (int c = 0; c < 4; ++c)
#pragma unroll
                        for (int jj = 0; jj < 4; ++jj) { const int key = k0 + 16 * c + 4 * q + jj; const bool ok = sel && key <= t && (br == 0 || key > t - 512); if (ok) bm = fmaxf(bm, s[ct][c][jj]); }
                    bm = qmax(bm);
                    mn = fmaxf(m[ct], bm); sc = __builtin_amdgcn_exp2f(m[ct] - mn); m[ct] = mn;
#pragma unroll
                    for (int c = 0; c < 4; ++c)
#pragma unroll
                        for (int jj = 0; jj < 4; ++jj) { const int key = k0 + 16 * c + 4 * q + jj; const bool ok = sel && key <= t && (br == 0 || key > t - 512);
                            const float e = ok ? __builtin_amdgcn_exp2f(s[ct][c][jj] - mn) : 0.f; s[ct][c][jj] = e; ls += e; }
                } else {
#pragma unroll
                    for (int c = 0; c < 4; ++c) bm = fmaxf(bm, fmaxf(fmaxf(s[ct][c][0], s[ct][c][1]), fmaxf(s[ct][c][2], s[ct][c][3])));
                    bm = sel ? bm : -1e30f;
                    bm = qmax(bm);
                    mn = fmaxf(m[ct], bm); sc = __builtin_amdgcn_exp2f(m[ct] - mn); m[ct] = mn;
                    const float mq = sel ? mn : 3e38f;
#pragma unroll
                    for (int c = 0; c < 4; ++c)
#pragma unroll
                        for (int jj = 0; jj < 4; ++jj) { const float e = __builtin_amdgcn_exp2f(s[ct][c][jj] - mq); s[ct][c][jj] = e; ls += e; }
                }
                l[ct] = l[ct] * sc + ls;
#pragma unroll
                for (int dt = 0; dt < 4; ++dt) o[ct][dt] = o[ct][dt] * sc;
                pf[ct][0] = frag_pk(s[ct][0], s[ct][1]); pf[ct][1] = frag_pk(s[ct][2], s[ct][3]);
            }
#pragma unroll
            for (int dt = 0; dt < 4; ++dt) { LAS unsigned char* vr = vb + (16 * dt + tk) * 144 + 8 * q;
                const bf16x8 va0 = frag_from2(lds_ld8(vr), lds_ld8(vr + 32)), va1 = frag_from2(lds_ld8(vr + 64), lds_ld8(vr + 96));
#pragma unroll
                for (int ct = 0; ct < 2; ++ct) { o[ct][dt] = MFMA16(va0, pf[ct][0], o[ct][dt]); o[ct][dt] = MFMA16(va1, pf[ct][1], o[ct][dt]); } }
        };
        int ja, jb, jcx; NSA_POP(ja); NSA_POP(jb); NSA_POP(jcx);
        u32x4 ka = {0u, 0u, 0u, 0u}, va = ka, kbr = ka, vbr = ka, kcr = ka, vcr = ka;
        NSA_LOAD(ja, ka, va); NSA_LOAD(jb, kbr, vbr); NSA_LOAD(jcx, kcr, vcr);
        for (;;) { NSA_STEP(ja, ka, va) NSA_STEP(jb, kbr, vbr) NSA_STEP(jcx, kcr, vcr) }
#undef NSA_POP
#undef NSA_LOAD
#undef NSA_STEP
#pragma unroll
        for (int ct = 0; ct < 2; ++ct) { float lt = l[ct]; lt = qsum(lt);
            const float gs = bf1(GN[btq[ct] * 32 + h * 3 + 1 + br]) / fmaxf(lt, 1e-30f);
#pragma unroll
            for (int dt = 0; dt < 4; ++dt) out[ct][dt] = out[ct][dt] + o[ct][dt] * gs; }
    }
#pragma unroll
    for (int ct = 0; ct < 2; ++ct)
#pragma unroll
        for (int dt = 0; dt < 4; ++dt) { bf16_t* op = ON + btq[ct] * 512 + h * 64 + 16 * dt + 4 * q; float c[4]; unpack4(ld8(op), c);
            *(u32x2*)op = pack4(c[0] + out[ct][dt][0], c[1] + out[ct][dt][1], c[2] + out[ct][dt][2], c[3] + out[ct][dt][3]); }
}

constexpr int SCAN_BUF = 49152;
__device__ __forceinline__ void scan_task(const Prm& p, LAS unsigned char* lds, int task, int tid, int wave, int lane, int& it) {
    const int bh = task >> 1, half = task & 1, b = bh >> 3, h = bh & 7;
    const int jq = lane & 15;
    const size_t base = (size_t)b * SEQ * 512 + h * 64;
    const bf16_t* src[3]; int dst[3]; bool act[3], isld[3], isneg[3];
#pragma unroll
    for (int kx = 0; kx < 3; ++kx) { const int e = tid + 512 * kx; const int ten = e >> 8, within = e & 255, tok = within >> 3, c8 = within & 7;
        act[kx] = e < 1408; isld[kx] = (ten == 1); isneg[kx] = (ten == 3);
        const unsigned char* bp = (ten == 0) ? (const unsigned char*)p.out + DO_SR : (ten == 1) ? (const unsigned char*)p.out + DO_SLD : (ten == 2) ? (const unsigned char*)p.out + DO_SK : (ten == 3) ? p.ws + WS_SKK : (ten == 4) ? p.ws + WS_SKKA : (const unsigned char*)p.out + DO_SV;
        if (ten < 5) { src[kx] = (const bf16_t*)bp + base + (size_t)tok * 512 + c8 * 8; dst[kx] = ten * 8192 + (tok * 64 + c8 * 8) * 4; }
        else { const int w2 = e - 1280, tok2 = w2 >> 2, c2 = w2 & 3; src[kx] = (const bf16_t*)bp + base + (size_t)tok2 * 512 + half * 32 + c2 * 8; dst[kx] = 40960 + (tok2 * 32 + c2 * 8) * 4; }
    }
    const int rg = lane >> 4, irow = half * 32 + (wave & 3) * 8 + rg * 2;
    bf16_t* Yf = (bf16_t*)(p.ws + WS_Y) + base + half * 32;
    f32x2 A01 = {0.f, 0.f}, A23 = {0.f, 0.f}, B01 = {0.f, 0.f}, B23 = {0.f, 0.f};
    const int ht = task * 2 + (wave - 4); const bool hact = (wave == 4 || wave == 5) && ht < 508;
    const int cwhich = ht / 254, ctile = ht - cwhich * 254, ctk = lane & 15, cq = lane >> 4, crow = ctile * 16 + ctk, cb = crow / 254, crem = crow - cb * 254, cn = crem >> 1, cg = crem & 1;
    const float* cpe = cwhich ? p.in[16] : p.in[15];
    const bf16_t* cW1 = (const bf16_t*)(p.ws + (cwhich ? WS_CV1T : WS_CK1T)) + (size_t)ctk * 2048 + 8 * cq;
    const bf16_t* csrc = (const bf16_t*)(p.ws + WS_KV6) + (size_t)(cb * SEQ + 16 * cn) * 768 + cwhich * 128 + cg * 64 + 8 * cq;
    f32x4 cacc[8];
#pragma unroll
    for (int c = 0; c < 8; ++c) cacc[c] = (f32x4){0.f, 0.f, 0.f, 0.f};
    u32x4 reg[3];
#pragma unroll
    for (int kx = 0; kx < 3; ++kx) reg[kx] = act[kx] ? ld16(src[kx]) : (u32x4){0u, 0u, 0u, 0u};
    for (int blk = 0; blk < SEQ / 32; ++blk) {
        LAS unsigned char* buf = lds + (it & 1) * SCAN_BUF; ++it;
#pragma unroll
        for (int kx = 0; kx < 3; ++kx) if (act[kx]) { float f[8]; unpack8(reg[kx], f);
            if (isld[kx]) {
#pragma unroll
                for (int x = 0; x < 8; ++x) f[x] = __expf(f[x]); }
            if (isneg[kx]) {
#pragma unroll
                for (int x = 0; x < 8; ++x) f[x] = -f[x]; }
            *(LAS f32x4*)(buf + dst[kx]) = (f32x4){f[0], f[1], f[2], f[3]}; *(LAS f32x4*)(buf + dst[kx] + 16) = (f32x4){f[4], f[5], f[6], f[7]}; }
        __syncthreads();
        if (blk + 1 < SEQ / 32) {
#pragma unroll
            for (int kx = 0; kx < 3; ++kx) if (act[kx]) reg[kx] = ld16(src[kx] + (size_t)(blk + 1) * 32 * 512); }
        if (tid >= 384 && blk > 0) {
            LAS unsigned char* yb = lds + ((it & 1)) * SCAN_BUF + 45056; const int ft = (tid - 384) >> 2, fc = (tid - 384) & 3;
            const f32x4 y0v = *(const LAS f32x4*)(yb + (ft * 32 + fc * 8) * 4), y1v = *(const LAS f32x4*)(yb + (ft * 32 + fc * 8 + 4) * 4);
            u32x4 o; o.x = pk2(y0v[0], y0v[1]); o.y = pk2(y0v[2], y0v[3]); o.z = pk2(y1v[0], y1v[1]); o.w = pk2(y1v[2], y1v[3]);
            *(u32x4*)(Yf + (size_t)((blk - 1) * 32 + ft) * 512 + fc * 8) = o; }
        if (wave >= 6) {
            bf16_t* KV6 = (bf16_t*)(p.ws + WS_KV6); const f32x2* rope = (const f32x2*)(p.ws + WS_ROPE);
            const int hidx = (task * 2 + (wave - 6)) * 64 + lane;
#pragma unroll
            for (int i = 0; i < 2; ++i) { const int e = hidx + 32768 * (2 * blk + i); const int d = e & 31, g = (e >> 5) & 1, wh = (e >> 6) & 1, bt = e >> 7;
                bf16_t* x = KV6 + (size_t)bt * 768 + (wh ? 512 : 256) + g * 64 + d; const float x1 = bf1(x[0]), x2 = bf1(x[32]); const f32x2 cs = rope[(bt & (SEQ - 1)) * 32 + d];
                x[0] = (bf16_t)f2bf(x1 * cs[0] - x2 * cs[1]); x[32] = (bf16_t)f2bf(x2 * cs[0] + x1 * cs[1]); }
            if (blk < 32) { const int e = hidx + 32768 * blk; const int d = e & 63, tc = (e >> 6) & 255, g = (e >> 14) & 1, b2 = (e >> 15) & 15, wh = e >> 19;
                const bf16_t* sv = KV6 + (size_t)(b2 * SEQ + 8 * tc) * 768 + (wh ? 640 : 384) + g * 64 + d;
                u32x4 o; o.x = (unsigned)sv[0] | ((unsigned)sv[768] << 16); o.y = (unsigned)sv[2 * 768] | ((unsigned)sv[3 * 768] << 16); o.z = (unsigned)sv[4 * 768] | ((unsigned)sv[5 * 768] << 16); o.w = (unsigned)sv[6 * 768] | ((unsigned)sv[7 * 768] << 16);
                *(u32x4*)((bf16_t*)(p.ws + (wh ? WS_VWT : WS_VST)) + ((size_t)((b2 * 2 + g) * 64 + d)) * SEQ + 8 * tc) = o; }
        }
        if (hact) { const int sx = blk, l = sx >> 1, d = (sx & 1) * 32;
            float f[8]; unpack8(ld16(csrc + (size_t)l * 768 + d), f);
            const f32x4 p0 = *(const f32x4*)(cpe + l * 64 + d + 8 * cq), p1 = *(const f32x4*)(cpe + l * 64 + d + 8 * cq + 4);
#pragma unroll
            for (int i = 0; i < 4; ++i) { f[i] += p0[i]; f[4 + i] += p1[i]; }
            const bf16x8 xb = pack8(f);
#pragma unroll
            for (int c = 0; c < 8; ++c) cacc[c] = MFMA16(frag_from(ld16(cW1 + (size_t)(16 * c) * 2048 + 32 * sx)), xb, cacc[c]); }
        if (wave < 4) {
            LAS unsigned char* lp = buf + jq * 16; LAS unsigned char* vp = buf + 40960 + ((wave & 3) * 8 + rg * 2) * 4;
            f32x4 nr = *(const LAS f32x4*)(lp), nw = *(const LAS f32x4*)(lp + 8192), nk = *(const LAS f32x4*)(lp + 16384), nkk = *(const LAS f32x4*)(lp + 24576), nka = *(const LAS f32x4*)(lp + 32768);
            f32x2 nv = *(const LAS f32x2*)(vp);
#pragma unroll
            for (int tt = 0; tt < 32; ++tt) {
                const f32x4 r = nr, w = nw, kv = nk, kk = nkk, ka = nka; const f32x2 v = nv;
                if (tt < 31) { nr = *(const LAS f32x4*)(lp + (tt + 1) * 256); nw = *(const LAS f32x4*)(lp + 8192 + (tt + 1) * 256); nk = *(const LAS f32x4*)(lp + 16384 + (tt + 1) * 256);
                    nkk = *(const LAS f32x4*)(lp + 24576 + (tt + 1) * 256); nka = *(const LAS f32x4*)(lp + 32768 + (tt + 1) * 256); nv = *(const LAS f32x2*)(vp + (tt + 1) * 128); }
                const f32x2 kk01 = {kk[0], kk[1]}, kk23 = {kk[2], kk[3]}, w01 = {w[0], w[1]}, w23 = {w[2], w[3]}, ka01 = {ka[0], ka[1]}, ka23 = {ka[2], ka[3]}, k01 = {kv[0], kv[1]}, k23 = {kv[2], kv[3]}, r01 = {r[0], r[1]}, r23 = {r[2], r[3]};
                const f32x2 da = A01 * kk01 + A23 * kk23, db = B01 * kk01 + B23 * kk23;
                float sa, sb; red16_pair(da[0] + da[1], db[0] + db[1], (lane & 1) != 0, sa, sb);
                A01 = A01 * w01 + ka01 * sa + k01 * v[0]; A23 = A23 * w23 + ka23 * sa + k23 * v[0];
                B01 = B01 * w01 + ka01 * sb + k01 * v[1]; B23 = B23 * w23 + ka23 * sb + k23 * v[1];
                const f32x2 ya = A01 * r01 + A23 * r23, yb = B01 * r01 + B23 * r23;
                const float yq = red16_pair_nb(ya[0] + ya[1], yb[0] + yb[1], (lane & 1) != 0);
                if (jq < 2) *(LAS float*)(buf + 45056 + (tt * 32 + (wave & 3) * 8 + rg * 2 + jq) * 4) = yq;
            }
        }
    }
    __syncthreads();
    if (tid >= 384) {
        LAS unsigned char* yb = lds + ((it - 1) & 1) * SCAN_BUF + 45056; const int ft = (tid - 384) >> 2, fc = (tid - 384) & 3;
        const f32x4 y0v = *(const LAS f32x4*)(yb + (ft * 32 + fc * 8) * 4), y1v = *(const LAS f32x4*)(yb + (ft * 32 + fc * 8 + 4) * 4);
        u32x4 o; o.x = pk2(y0v[0], y0v[1]); o.y = pk2(y0v[2], y0v[3]); o.z = pk2(y1v[0], y1v[1]); o.w = pk2(y1v[2], y1v[3]);
        *(u32x4*)(Yf + (size_t)((SEQ / 32 - 1) * 32 + ft) * 512 + fc * 8) = o; }
    if (hact) {
        const bf16_t* W2 = (const bf16_t*)(p.ws + (cwhich ? WS_CV2T : WS_CK2T));
#pragma unroll
        for (int c = 0; c < 8; ++c) { cacc[c][0] = gelu_t(cacc[c][0]); cacc[c][1] = gelu_t(cacc[c][1]); cacc[c][2] = gelu_t(cacc[c][2]); cacc[c][3] = gelu_t(cacc[c][3]); }
        bf16_t* kc = (bf16_t*)(p.ws + WS_KCMP); bf16_t* vct = (bf16_t*)(p.ws + WS_VCMPT);
#pragma unroll
        for (int ot = 0; ot < 4; ++ot) {
            f32x4 d2 = {0.f, 0.f, 0.f, 0.f};
#pragma unroll
            for (int s2 = 0; s2 < 4; ++s2) { const bf16_t* w = W2 + (16 * ot + ctk) * 128 + 32 * s2 + 4 * cq;
                d2 = MFMA16(frag_from2(ld8(w), ld8(w + 16)), frag_pk(cacc[2 * s2], cacc[2 * s2 + 1]), d2); }
            const int o = 16 * ot + 4 * cq;
            if (cwhich == 0) *(u32x2*)(kc + ((size_t)((cb * 2 + cg) * 128 + cn)) * 64 + o) = pack4(d2[0], d2[1], d2[2], d2[3]);
            else {
#pragma unroll
                for (int j = 0; j < 4; ++j) vct[((size_t)((cb * 2 + cg) * 64 + o + j)) * 128 + cn] = (bf16_t)f2bf(d2[j]); }
        }
    }
}
__device__ __forceinline__ void rw_post_token(const Prm& p, int bt, int lane) {
    const size_t o = (size_t)bt * 512 + 8 * lane;
    bf16_t* Y = (bf16_t*)(p.ws + WS_Y);
    float y[8], r[8], k[8], v[8], g[8];
    unpack8(ld16(Y + o), y); unpack8(ld16((const bf16_t*)((const unsigned char*)p.out + DO_SR) + o), r); unpack8(ld16((const bf16_t*)((const unsigned char*)p.out + DO_SK) + o), k);
    unpack8(ld16((const bf16_t*)((const unsigned char*)p.out + DO_SV) + o), v); unpack8(ld16((const bf16_t*)(p.ws + WS_G) + o), g);
    const float* rk = p.in[12] + 8 * lane; const float* lg = p.in[13] + 8 * lane; const float* lb = p.in[14] + 8 * lane;
    float s = 0.f, dot = 0.f;
#pragma unroll
    for (int i = 0; i < 8; ++i) { s += y[i]; dot += r[i] * k[i] * rk[i]; }
    s += __shfl_xor(s, 1); s += __shfl_xor(s, 2); s += __shfl_xor(s, 4); dot += __shfl_xor(dot, 1); dot += __shfl_xor(dot, 2); dot += __shfl_xor(dot, 4);
    const float mu = s * (1.0f / 64.0f); float vs = 0.f;
#pragma unroll
    for (int i = 0; i < 8; ++i) { const float d = y[i] - mu; vs += d * d; }
    vs += __shfl_xor(vs, 1); vs += __shfl_xor(vs, 2); vs += __shfl_xor(vs, 4);
    const float rs = rsqrtf(vs * (1.0f / 64.0f) + 64e-5f);
    float out[8];
#pragma unroll
    for (int i = 0; i < 8; ++i) out[i] = ((y[i] - mu) * rs * lg[i] + lb[i] + dot * v[i]) * g[i];
    *(u32x4*)(Y + o) = __builtin_bit_cast(u32x4, pack8(out));
}

constexpr int XA_KB = 33792, XA_BUF = 70656;
__device__ __forceinline__ void xattn_wg_task(const Prm& p, LAS unsigned char* lds, int task, int tid, int wave, int lane, int& it) {
    const int tile = task & 15, h = (task >> 4) & 3, b = task >> 6, tk = lane & 15, q = lane >> 4;
    const size_t bt = (size_t)b * SEQ + tile * 128 + wave * 16 + tk;
    const bf16_t* QX = (const bf16_t*)(p.ws + WS_QX) + bt * 1024 + h * 256 + 8 * q;
    const bf16_t* Kg = (const bf16_t*)(p.ws + WS_KX) + (size_t)b * 256 * 1024 + h * 256;
    const bf16_t* Vg = (const bf16_t*)(p.ws + WS_VXT) + (size_t)(b * 4 + h) * 256 * 256;
    bf16_t* OX = (bf16_t*)(p.ws + WS_OX) + bt * 1024 + h * 256;
    bf16x8 qf[8];
#pragma unroll
    for (int s = 0; s < 8; ++s) qf[s] = frag_from(ld16(QX + 32 * s));
    u32x4 kr[4], vr[4];
#pragma unroll
    for (int i = 0; i < 4; ++i) { const int idx = tid + 512 * i; kr[i] = ld16(Kg + (size_t)(idx >> 5) * 1024 + (idx & 31) * 8); vr[i] = ld16(Vg + (size_t)(idx >> 3) * 256 + (idx & 7) * 8); }
    float m = -1e30f, l = 0.f; f32x4 o[16];
#pragma unroll
    for (int dt = 0; dt < 16; ++dt) o[dt] = (f32x4){0.f, 0.f, 0.f, 0.f};
#pragma unroll 1
    for (int blk = 0; blk < 4; ++blk) {
        LAS unsigned char* kb = lds + (it & 1) * XA_BUF; LAS unsigned char* vb = kb + XA_KB; ++it;
#pragma unroll
        for (int i = 0; i < 4; ++i) { const int idx = tid + 512 * i; *(LAS u32x4*)(kb + (idx >> 5) * 528 + (idx & 31) * 16) = kr[i]; *(LAS u32x4*)(vb + (idx >> 3) * 144 + (idx & 7) * 16) = vr[i]; }
        __syncthreads();
        if (blk < 3) { const int k0 = 64 * (blk + 1);
#pragma unroll
            for (int i = 0; i < 4; ++i) { const int idx = tid + 512 * i; kr[i] = ld16(Kg + (size_t)(k0 + (idx >> 5)) * 1024 + (idx & 31) * 8); vr[i] = ld16(Vg + (size_t)(idx >> 3) * 256 + k0 + (idx & 7) * 8); } }
        f32x4 sc[4]; float bm = -1e30f;
#pragma unroll
        for (int c = 0; c < 4; ++c) { f32x4 a = {0.f, 0.f, 0.f, 0.f}; LAS unsigned char* kp = kb + (16 * c + tk) * 528 + 16 * q;
#pragma unroll
            for (int s = 0; s < 8; ++s) a = MFMA16(frag_from(lds_ld16(kp + 64 * s)), qf[s], a);
            a = a * 0.0625f; sc[c] = a; bm = fmaxf(bm, fmaxf(fmaxf(a[0], a[1]), fmaxf(a[2], a[3]))); }
        bm = qmax(bm);
        const float mn = fmaxf(m, bm), scl = __expf(m - mn); m = mn; float ls = 0.f;
#pragma unroll
        for (int c = 0; c < 4; ++c)
#pragma unroll
            for (int j = 0; j < 4; ++j) { const float e = __expf(sc[c][j] - mn); sc[c][j] = e; ls += e; }
        l = l * scl + ls;
        const bf16x8 pf0 = frag_pk(sc[0], sc[1]), pf1 = frag_pk(sc[2], sc[3]);
#pragma unroll
        for (int dt = 0; dt < 16; ++dt) { LAS unsigned char* vp = vb + (16 * dt + tk) * 144 + 8 * q;
            o[dt] = o[dt] * scl;
            o[dt] = MFMA16(frag_from2(lds_ld8(vp), lds_ld8(vp + 32)), pf0, o[dt]); o[dt] = MFMA16(frag_from2(lds_ld8(vp + 64), lds_ld8(vp + 96)), pf1, o[dt]); }
    }
    l = qsum(l);
    const float il = 1.0f / l;
#pragma unroll
    for (int dt = 0; dt < 16; ++dt) *(u32x2*)(OX + 16 * dt + 4 * q) = pack4(o[dt][0] * il, o[dt][1] * il, o[dt][2] * il, o[dt][3] * il);
}

#define XB_TMO      128
#define XB_XCNT(j)  (256  + 64 * (j))
#define XB_XSUB(j)  (1280 + 64 * (j))
#define XB_XGEN(j)  (2304 + 64 * (j))
#define XB_TOP      3328
#define XB_TOPGEN   3392
#define XCD_BAR_WORDS 3456
#define XB_SPIN_CAP (1u << 18)

__device__ __forceinline__ unsigned xb_ld(unsigned* p)              { return __hip_atomic_load(p, __ATOMIC_RELAXED, __HIP_MEMORY_SCOPE_AGENT); }
__device__ __forceinline__ unsigned xb_add(unsigned* p, unsigned v) { return __hip_atomic_fetch_add(p, v, __ATOMIC_RELAXED, __HIP_MEMORY_SCOPE_AGENT); }
__device__ __forceinline__ unsigned xb_xcc_id() { return (unsigned)__builtin_amdgcn_s_getreg((3 << 11) | 20) & 0xFu; }
#define XB_SPIN(cond, bar) do { unsigned _sp = 0; while (cond) { __builtin_amdgcn_s_sleep(1); \
    if ((++_sp & 255u) == 0u) { if (xb_ld(&(bar)[XB_TMO])) break; if (_sp > XB_SPIN_CAP) { atomicAdd(&(bar)[XB_TMO], 1u); break; } } } } while (0)

struct XcdBarrier {
    unsigned* bar; unsigned x;
    volatile LAS unsigned* st;
};

__device__ __forceinline__ XcdBarrier xcd_barrier_post(unsigned* bar, volatile LAS unsigned* st) {
    XcdBarrier b; b.bar = bar; b.x = xb_xcc_id(); b.st = st;
    if (threadIdx.x == 0) (void)xb_add(&bar[XB_XCNT(b.x)], 1u);
    return b;
}
__device__ __forceinline__ void xcd_barrier_complete(unsigned* bar, unsigned x, unsigned& nloc, unsigned& nx) {
    const unsigned G = gridDim.x * gridDim.y * gridDim.z;
    unsigned sum, cnt, mine, sp = 0u;
    for (;;) {
        sum = 0u; cnt = 0u; mine = 0u;
#pragma unroll
        for (unsigned j = 0; j < 16; ++j) { const unsigned c = xb_ld(&bar[XB_XCNT(j)]); sum += c; cnt += (c > 0u) ? 1u : 0u; mine = (j == x) ? c : mine; }
        if (sum == G) break;
        __builtin_amdgcn_s_sleep(1);
        if ((++sp & 255u) == 0u) { if (xb_ld(&bar[XB_TMO])) break; if (sp > XB_SPIN_CAP) { atomicAdd(&bar[XB_TMO], 1u); break; } }
    }
    nloc = mine > 0u ? mine : 1u; nx = cnt > 0u ? cnt : 1u;
}

__device__ __forceinline__ void xcd_barrier(const XcdBarrier& b) {
    asm volatile("s_waitcnt vmcnt(0)" ::: "memory");
    __syncthreads();
    if (threadIdx.x == 0) {
        unsigned* bar = b.bar;
        __builtin_amdgcn_s_waitcnt(0);
        unsigned nloc = b.st[0], nx = b.st[1];
        if (nloc == 0u) { xcd_barrier_complete(bar, b.x, nloc, nx); b.st[0] = nloc; b.st[1] = nx; }
        const unsigned old = xb_add(&bar[XB_XSUB(b.x)], 1u);
        const unsigned gen = old / nloc;
        if (old + 1u == (gen + 1u) * nloc) {
            __builtin_amdgcn_fence(__ATOMIC_RELEASE, "agent");
            asm volatile("s_waitcnt vmcnt(0)" ::: "memory");
            const unsigned og = xb_add(&bar[XB_TOP], 1u);
            const unsigned tg = og / nx;
            if (og + 1u == (tg + 1u) * nx) xb_add(&bar[XB_TOPGEN], 1u);
            else XB_SPIN(xb_ld(&bar[XB_TOPGEN]) == tg, bar);
            __builtin_amdgcn_fence(__ATOMIC_ACQUIRE, "agent");
            xb_add(&bar[XB_XGEN(b.x)], 1u);
            asm volatile("s_waitcnt vmcnt(0)" ::: "memory");
        } else {
            XB_SPIN(xb_ld(&bar[XB_XGEN(b.x)]) == gen, bar);
            __builtin_amdgcn_fence(__ATOMIC_ACQUIRE, "agent");
            asm volatile("s_waitcnt vmcnt(0)" ::: "memory");
        }
    }
    __syncthreads();
}

__global__ void __launch_bounds__(512, 2) hybrid_fwd(Prm p, int ph_lo, int ph_hi) {
    extern __shared__ __attribute__((aligned(16))) unsigned char lds_raw[];
    LAS unsigned char* lds = (LAS unsigned char*)lds_raw;
    cg::grid_group grid = cg::this_grid();
    const int tid = threadIdx.x, lane = tid & 63, wave = __builtin_amdgcn_readfirstlane(tid >> 6);
    const int G = gridDim.x, gw = blockIdx.x * 8 + wave, NGW = G * 8, gt = blockIdx.x * 512 + tid, NGT = G * 512;
    unsigned char* ws = p.ws;
    volatile LAS unsigned* bst = (volatile LAS unsigned*)(lds + LDS_BYTES - 64);
    if (tid < 16) bst[tid] = 0u;
    __syncthreads();
    XcdBarrier xbar = xcd_barrier_post((unsigned*)ws, bst);
    if (ph_lo < 0) grid.sync();
#define GSYNC() xcd_barrier(xbar)
#ifndef DUP_MASK
#define DUP_MASK 0
#endif
#define PHASE(k, ...) if (ph_lo <= (k) && (k) < ph_hi) { _Pragma("unroll 1") for (int rep = 0; rep <= ((DUP_MASK >> (k)) & 1); ++rep) { __VA_ARGS__ if (rep < ((DUP_MASK >> (k)) & 1)) GSYNC(); } } if (ph_lo <= (k) && (k) + 1 < ph_hi) GSYNC();
    PHASE(0, {
        LAS float* scr = (LAS float*)(lds + wave * 8448); int off = gw;
        transpose_w(p.in[3], 1024, 5144, (bf16_t*)(ws + WS_WIN), 1, scr, lane, off, NGW);
        transpose_w(p.in[30], 1024, 5632, (bf16_t*)(ws + WS_WGU), 2, scr, lane, off, NGW, p.in[29]);
        transpose_w(p.in[31], 2816, 1024, (bf16_t*)(ws + WS_WDOWN), 0, scr, lane, off, NGW);
        transpose_w(p.in[27], 1024, 2048, (bf16_t*)(ws + WS_WKV), 0, scr, lane, off, NGW);
        transpose_w(p.in[23], 1024, 1024, (bf16_t*)(ws + WS_WOUT), 0, scr, lane, off, NGW);
        transpose_w(p.in[26], 1024, 1024, (bf16_t*)(ws + WS_WQ), 0, scr, lane, off, NGW, p.in[24]);
        transpose_w(p.in[28], 1024, 1024, (bf16_t*)(ws + WS_WO), 0, scr, lane, off, NGW);
        transpose_w(p.in[21], 512, 1024, (bf16_t*)(ws + WS_WUPRW), 0, scr, lane, off, NGW);
        transpose_w(p.in[22], 512, 1024, (bf16_t*)(ws + WS_WUPNSA), 0, scr, lane, off, NGW);
        transpose_w(p.in[5], 64, 512, (bf16_t*)(ws + WS_LORA_W), 0, scr, lane, off, NGW);
        transpose_w(p.in[7], 64, 512, (bf16_t*)(ws + WS_LORA_A), 0, scr, lane, off, NGW);
        transpose_w(p.in[9], 128, 512, (bf16_t*)(ws + WS_LORA_G), 0, scr, lane, off, NGW);
        transpose_w(p.in[17], 2048, 128, (bf16_t*)(ws + WS_CK1T), 0, scr, lane, off, NGW);
        transpose_w(p.in[19], 2048, 128, (bf16_t*)(ws + WS_CV1T), 0, scr, lane, off, NGW);
        transpose_w(p.in[18], 128, 64, (bf16_t*)(ws + WS_CK2T), 0, scr, lane, off, NGW);
        transpose_w(p.in[20], 128, 64, (bf16_t*)(ws + WS_CV2T), 0, scr, lane, off, NGW);
        for (int e = gt; e < (NIN - 5144) * 1024 / 2; e += NGT) ((unsigned*)(ws + WS_WIN + (size_t)5144 * 1024 * 2))[e] = 0u;
        for (int e = gt; e < SEQ * 32; e += NGT) { const int d = e & 31, t = e >> 5; const float inv = powf(10000.0f, -(float)d / 32.0f); const float ang = (float)t * inv;
            const double rev = (double)ang * 0.15915494309189535; const float fr = (float)(rev - rint(rev));
            ((f32x2*)(ws + WS_ROPE))[e] = (f32x2){__builtin_amdgcn_cosf(fr), __builtin_amdgcn_sinf(fr)}; }
        for (int e = gt; e < 32 * 64; e += NGT) { const int bg = e >> 6, d = e & 63; ((bf16_t*)(ws + WS_KCMP))[(size_t)(bg * 128 + 127) * 64 + d] = 0; ((bf16_t*)(ws + WS_VCMPT))[(size_t)(bg * 64 + d) * 128 + 127] = 0; }
        norm_rows(p.in[0], p.in[2], (bf16_t*)(ws + WS_XN), MTOK, lane, gw, NGW);
        norm_rows(p.in[1], p.in[25], (bf16_t*)(ws + WS_MEMN), BATCH * NMEM, lane, gw, NGW);
    })
    PHASE(1, {
        EpiInProj E{(bf16_t*)(ws + WS_PRW), (bf16_t*)(ws + WS_Q), (bf16_t*)(ws + WS_KV6), (bf16_t*)(ws + WS_GM), (bf16_t*)(ws + WS_GN)};
        run_gemm(lds, (const bf16_t*)(ws + WS_XN), (const bf16_t*)(ws + WS_WIN), MTOK, NIN, 1024, E);
        EpiMemK E2{(bf16_t*)(ws + WS_KX)};
        run_gemm(lds, (const bf16_t*)(ws + WS_MEMN), (const bf16_t*)(ws + WS_WKV), BATCH * NMEM, 1024, 1024, E2, 128);
        EpiMemVT E3{(bf16_t*)(ws + WS_VXT)};
        run_gemm(lds, (const bf16_t*)(ws + WS_WKV) + (size_t)1024 * 1024, (const bf16_t*)(ws + WS_MEMN), 1024, BATCH * NMEM, 1024, E3, 64);
    })
    PHASE(2, {
        for (int t8 = blockIdx.x; t8 < MTOK / 128; t8 += G) rw_prep_task(p, lds, t8 * 8 + wave, tid, wave, lane);
    })
    PHASE(3, { int itc = 0; for (int task = blockIdx.x; task < 256; task += G) scan_task(p, lds, task, tid, wave, lane, itc); })
    PHASE(4, { for (int wt = blockIdx.x; wt < 512; wt += G) {
            const int bg = wt >> 4; LAS unsigned char* kb = lds; LAS unsigned char* vb = lds + 18432;
            const bf16_t* kc = (const bf16_t*)(ws + WS_KCMP) + (size_t)bg * 128 * 64; const bf16_t* vct = (const bf16_t*)(ws + WS_VCMPT) + (size_t)bg * 64 * 128;
            __syncthreads();
            _Pragma("unroll") for (int i = 0; i < 2; ++i) { const int idx = tid + 512 * i; *(LAS u32x4*)(kb + (idx >> 3) * 144 + (idx & 7) * 16) = ld16(kc + (idx >> 3) * 64 + (idx & 7) * 8); *(LAS u32x4*)(vb + (idx >> 4) * 272 + (idx & 15) * 16) = ld16(vct + (idx >> 4) * 128 + (idx & 15) * 8); }
            __syncthreads();
            cmp_attn_task(p, kb, vb, (bg << 7) + ((wt & 15) << 3) + wave, lane); }
        GSYNC();
        { int itc = 0; for (int k = blockIdx.x; k < 1024; k += G) nsa_wg_task(p, lds, k, tid, wave, lane, itc); }
          for (int bt = gw; bt < MTOK; bt += NGW) rw_post_token(p, bt, lane); })
    PHASE(7, { { EpiGate1 E{(const bf16_t*)(ws + WS_GM), (bf16_t*)(ws + WS_T1)};
        run_gemm(lds, (const bf16_t*)(ws + WS_Y), (const bf16_t*)(ws + WS_WUPRW), MTOK, 1024, 512, E); }
        { EpiGate2 E{(const bf16_t*)(ws + WS_GM), (bf16_t*)(ws + WS_T1)};
        run_gemm(lds, (const bf16_t*)(ws + WS_ONSA), (const bf16_t*)(ws + WS_WUPNSA), MTOK, 1024, 512, E); } })
    PHASE(9, { EpiResidH E{p.in[0], nullptr, (bf16_t*)(ws + WS_XN2), (float*)(ws + WS_SSQ)}; run_gemm(lds, (const bf16_t*)(ws + WS_T1), (const bf16_t*)(ws + WS_WOUT), MTOK, 1024, 1024, E); })
    PHASE(11, { EpiBf16S E{(bf16_t*)(ws + WS_QX), 1024, (const float*)(ws + WS_SSQ)}; run_gemm(lds, (const bf16_t*)(ws + WS_XN2), (const bf16_t*)(ws + WS_WQ), MTOK, 1024, 1024, E); })
    PHASE(12, { int itc = 0; for (int task = blockIdx.x; task < 1024; task += G) xattn_wg_task(p, lds, task, tid, wave, lane, itc); })
    PHASE(13, { EpiResidH E{nullptr, (const bf16_t*)(ws + WS_XN2), (bf16_t*)(ws + WS_XN2), (float*)(ws + WS_SSQ)}; run_gemm(lds, (const bf16_t*)(ws + WS_OX), (const bf16_t*)(ws + WS_WO), MTOK, 1024, 1024, E); })
    PHASE(15, { EpiSwiglu E{(bf16_t*)(ws + WS_HFF), (const float*)(ws + WS_SSQ)}; run_gemm(lds, (const bf16_t*)(ws + WS_XN2), (const bf16_t*)(ws + WS_WGU), MTOK, 2 * DFF, 1024, E); })
    PHASE(16, { EpiResidH E{nullptr, (const bf16_t*)(ws + WS_XN2), (bf16_t*)(ws + WS_OX), (float*)(ws + WS_SSQ)}; run_gemm(lds, (const bf16_t*)(ws + WS_HFF), (const bf16_t*)(ws + WS_WDOWN), MTOK, 1024, DFF, E); })
    PHASE(17, {
        const float* gain = p.in[32]; const bf16_t* hb = (const bf16_t*)(ws + WS_OX); const float* ssq = (const float*)(ws + WS_SSQ);
        f32x4 gv[4];
        _Pragma("unroll") for (int j = 0; j < 4; ++j) gv[j] = ((const f32x4*)gain)[lane + 64 * j];
        for (int m = gw; m < MTOK; m += NGW) {
            u32x2 hv[4];
            _Pragma("unroll") for (int j = 0; j < 4; ++j) hv[j] = ld8(hb + (size_t)m * DM + 4 * (lane + 64 * j));
            const float rs = row_rs(ssq, m);
            f32x4* xo = (f32x4*)(p.out + (size_t)m * DM) + lane;
            _Pragma("unroll") for (int j = 0; j < 4; ++j) { float a[4]; unpack4(hv[j], a); xo[64 * j] = (f32x4){a[0], a[1], a[2], a[3]} * rs * gv[j]; }
        }
    })
#undef PHASE
}

constexpr int NPHASE = 18;
#ifndef MK_MULTI
#define MK_MULTI 0
#endif
extern "C" void kernel_launch(void* const* d_in, const int* in_sizes, int n_in, void* d_out, int out_size, void* d_ws, size_t ws_size, hipStream_t stream) {
    static int grid = 0;
    if (grid == 0) {
        if (n_in != 33 || out_size != MTOK * DM || ws_size < WS_NEED) { fprintf(stderr, "kernel_launch: unexpected shapes (n_in %d out %d ws %zu)\n", n_in, out_size, ws_size); grid = -1; return; }
        int dev = 0, cus = 0, per_cu = 0;
        (void)hipGetDevice(&dev); (void)hipDeviceGetAttribute(&cus, hipDeviceAttributeMultiprocessorCount, dev);
        (void)hipFuncSetAttribute((const void*)hybrid_fwd, hipFuncAttributeMaxDynamicSharedMemorySize, LDS_BYTES);
        (void)hipOccupancyMaxActiveBlocksPerMultiprocessor(&per_cu, (const void*)hybrid_fwd, 512, LDS_BYTES);
        if (per_cu < 1) { fprintf(stderr, "kernel_launch: occupancy query says %d blocks/CU\n", per_cu); per_cu = 1; }
        grid = cus * 1;
        (void)hipGetLastError();
    }
    if (grid < 0) return;
    if (hipMemsetAsync(d_ws, 0, 16384, stream) != hipSuccess) { fprintf(stderr, "kernel_launch: memset of barrier words failed\n"); return; }
    Prm p{};
    for (int i = 0; i < 33; ++i) p.in[i] = (const float*)d_in[i];
    p.out = (float*)d_out; p.ws = (unsigned char*)d_ws;
#if MK_MULTI
    for (int k = 0; k < NPHASE; ++k) { int lo = k, hi = k + 1; hipLaunchKernelGGL(hybrid_fwd, dim3(grid), dim3(512), LDS_BYTES, stream, p, lo, hi); }
#else
    int lo = 0, hi = NPHASE; void* args[] = {&p, &lo, &hi};
    hipError_t e = hipLaunchCooperativeKernel((const void*)hybrid_fwd, dim3(grid), dim3(512), args, LDS_BYTES, stream);
    if (e != hipSuccess) fprintf(stderr, "cooperative launch failed: %s (grid %d)\n", hipGetErrorString(e), grid);
#endif
}
```
